# Optimizing an MI355X kernel written in HIP

```python
import jax, jax.numpy as jnp
from jax import lax
import numpy as np

D_MODEL = 2048
BATCH = 4
SEQ = 2048
DEPTH = 1

D_MIX = D_MODEL
ATT_WIDTH = D_MIX // 2
ATT_HEAD_DIM = 64
ATT_HEADS = ATT_WIDTH // ATT_HEAD_DIM
DILATED_PAIRS = ((128, 1), (512, 4), (2048, 16))
ATT_BLOCK = 128
ROT_DIM = ATT_HEAD_DIM // 4
ROPE_THETA = 500000.0
HG_WIDTH = D_MIX - ATT_WIDTH
HG_EXPAND = 128
HG_HEADS = HG_WIDTH // HG_EXPAND
HG_HEAD_K = HG_EXPAND
HG_HEAD_V = HG_WIDTH // HG_HEADS
HG_CHUNK = 64
IN_COLS = 3 * ATT_WIDTH + 4 * HG_WIDTH
N_EXPERTS = 32
TOP_K = 4
D_FF_EXPERT = D_MODEL
SWIGLU_ALPHA = 1.702
SWIGLU_LIMIT = 7.0
MOE_BLOCK = 128
ALPHA_DEEPNORM = (2.0 * DEPTH) ** 0.25
BETA_DEEPNORM = (8.0 * DEPTH) ** -0.25
LN_EPS = 1e-5
RMS_EPS = 1e-6
NEG_INF = -1e30

kernel_name = "hymba_dilated_hgrn2_moe_deepnorm_adaln"


def layer_norm(t, g, b):
    t32 = t.astype(jnp.float32)
    mu = jnp.mean(t32, axis=-1, keepdims=True)
    var = jnp.mean(jnp.square(t32 - mu), axis=-1, keepdims=True)
    return ((t32 - mu) * lax.rsqrt(var + LN_EPS) * g + b).astype(t.dtype)


def partial_rope(t, positions):
    half = ROT_DIM // 2
    inv = ROPE_THETA ** (-(jnp.arange(0, ROT_DIM, 2, dtype=jnp.float32) / ROT_DIM))
    ang = positions.astype(jnp.float32)[..., None] * inv
    cos = jnp.cos(ang)[:, :, None, :]
    sin = jnp.sin(ang)[:, :, None, :]
    x1, x2, rest = t[..., :half], t[..., half:ROT_DIM], t[..., ROT_DIM:]
    return jnp.concatenate([x1 * cos - x2 * sin, x1 * sin + x2 * cos, rest], axis=-1)


def dilated_branch(q, k, v, window, dilation):
    B_, S_, H_, Dh = q.shape
    w_steps = window // dilation
    Q = ATT_BLOCK
    nb = -(-S_ // (dilation * Q))
    S_pad = nb * Q * dilation
    pad = ((0, 0), (0, S_pad - S_), (0, 0), (0, 0))

    def to_streams(t):
        return jnp.pad(t, pad).reshape(B_, nb, Q, dilation, H_, Dh)

    def with_prev(t):
        prev = jnp.pad(t, ((0, 0), (1, 0), (0, 0), (0, 0), (0, 0), (0, 0)))[:, :-1]
        return jnp.concatenate([prev, t], axis=2)

    qs = to_streams(q)
    kb = with_prev(to_streams(k))
    vb = with_prev(to_streams(v))
    s = jnp.einsum('bnqrhd,bnkrhd->bnrhqk', qs, kb) * (Dh ** -0.5)
    qi = jnp.arange(Q)[:, None]
    kj = jnp.arange(2 * Q)[None, :]
    dist = qi + Q - kj
    blk = jnp.arange(nb)[:, None, None]
    valid = (dist >= 0) & (dist <= w_steps) & ((blk > 0) | (kj >= Q))
    s = jnp.where(valid[None, :, None, None], s, NEG_INF)
    m = jnp.max(s, axis=-1, keepdims=True)
    p = jnp.exp(s - m)
    den = jnp.sum(p, axis=-1)
    o = jnp.einsum('bnrhqk,bnkrhd->bnqrhd', p, vb)
    o = o / jnp.moveaxis(den, -1, 2)[..., None]
    lse = jnp.moveaxis(m[..., 0] + jnp.log(den), -1, 2)
    o = o.reshape(B_, S_pad, H_, Dh)[:, :S_]
    lse = lse.reshape(B_, S_pad, H_)[:, :S_]
    return o, lse


def dilated_attention(q, k, v, positions):
    B_, S_, _ = q.shape
    shp = (B_, S_, ATT_HEADS, ATT_HEAD_DIM)
    qh = partial_rope(q.reshape(shp).astype(jnp.float32), positions)
    kh = partial_rope(k.reshape(shp).astype(jnp.float32), positions)
    vh = v.reshape(shp).astype(jnp.float32)
    outs, lses = [], []
    for window, dilation in DILATED_PAIRS:
        o, lse = dilated_branch(qh, kh, vh, window, dilation)
        outs.append(o)
        lses.append(lse)
    wts = jax.nn.softmax(jnp.stack(lses, axis=0), axis=0)
    o = jnp.sum(wts[..., None] * jnp.stack(outs, axis=0), axis=0)
    return o.reshape(B_, S_, ATT_WIDTH)


def hgrn2(q, f_logit, i, gate, lb, gnorm_w):
    B_, S_, _ = q.shape
    nc = S_ // HG_CHUNK
    f = lb + (1.0 - lb) * jax.nn.sigmoid(f_logit.astype(jnp.float32))
    log_f = jnp.log(f)
    k = 1.0 - f

    def chunks(t):
        return t.astype(jnp.float32).reshape(B_, nc, HG_CHUNK, HG_HEADS, -1).transpose(1, 0, 3, 2, 4)

    qc, kc, vc, gc = chunks(q), chunks(k), chunks(i), chunks(log_f)
    causal = jnp.tril(jnp.ones((HG_CHUNK, HG_CHUNK), dtype=bool))[:, :, None]

    def step(state, inp):
        qb, kb, vb, gb = inp
        b = jnp.cumsum(gb, axis=2)
        o_inter = jnp.einsum('bhtk,bhkv->bhtv', qb * jnp.exp(b), state)
        diff = b[:, :, :, None, :] - b[:, :, None, :, :]
        decay = jnp.exp(jnp.where(causal, diff, NEG_INF))
        a = jnp.einsum('bhtk,bhsk,bhtsk->bhts', qb, kb, decay)
        o = o_inter + jnp.einsum('bhts,bhsv->bhtv', a, vb)
        b_last = b[:, :, -1:, :]
        new_state = jnp.exp(b_last[:, :, 0, :])[..., None] * state + jnp.einsum(
            'bhsk,bhsv->bhkv', kb * jnp.exp(b_last - b), vb)
        return new_state, o

    s0 = jnp.zeros((B_, HG_HEADS, HG_HEAD_K, HG_HEAD_V), jnp.float32)
    _, o = lax.scan(step, s0, (qc, kc, vc, gc))
    o = o.transpose(1, 0, 3, 2, 4).reshape(B_, S_, HG_HEADS, HG_HEAD_V)
    o = o * lax.rsqrt(jnp.mean(jnp.square(o), axis=-1, keepdims=True) + RMS_EPS)
    o = o * gnorm_w.astype(jnp.float32).reshape(HG_HEADS, HG_HEAD_V)
    o = o * jax.nn.silu(gate.astype(jnp.float32)).reshape(B_, S_, HG_HEADS, HG_HEAD_V)
    return o.reshape(B_, S_, HG_WIDTH)


def hybrid_mixer(h, positions, w_in, lb, gnorm_w, w_o):
    proj = h @ w_in
    A, G = ATT_WIDTH, HG_WIDTH
    q_a, k_a, v_a, q_r, f_r, i_r, g_r = jnp.split(
        proj, [A, 2 * A, 3 * A, 3 * A + G, 3 * A + 2 * G, 3 * A + 3 * G], axis=-1)
    att = dilated_attention(q_a, k_a, v_a, positions)
    rec = hgrn2(q_r, f_r, i_r, g_r, lb, gnorm_w)
    mixed = jnp.concatenate([att, rec], axis=-1).astype(h.dtype)
    return mixed @ w_o


def moe_ffn(h, router_w, router_b, w1, b1, w2, b2):
    B_, S_, D_ = h.shape
    T = B_ * S_
    hf = h.reshape(T, D_)
    logits = hf.astype(jnp.float32) @ router_w.astype(jnp.float32) + router_b.astype(jnp.float32)
    top_val, top_idx = lax.top_k(logits, TOP_K)
    gates = jax.nn.softmax(top_val, axis=-1)
    n_assign = T * TOP_K
    flat_e = top_idx.reshape(n_assign).astype(jnp.int32)
    flat_tok = jnp.arange(n_assign, dtype=jnp.int32) // TOP_K
    order = jnp.argsort(flat_e)
    sorted_e = flat_e[order]
    sorted_tok = flat_tok[order]
    sorted_gate = gates.reshape(n_assign)[order]
    counts = jnp.zeros((N_EXPERTS,), jnp.int32).at[flat_e].add(1)
    starts = jnp.cumsum(counts) - counts
    padded = (counts + MOE_BLOCK - 1) // MOE_BLOCK * MOE_BLOCK
    pends = jnp.cumsum(padded)
    pstarts = pends - padded
    dest = pstarts[sorted_e] + jnp.arange(n_assign, dtype=jnp.int32) - starts[sorted_e]
    n_rows = -(-n_assign // MOE_BLOCK) * MOE_BLOCK + N_EXPERTS * MOE_BLOCK
    n_rblk = n_rows // MOE_BLOCK
    row_tok = jnp.zeros((n_rows,), jnp.int32).at[dest].set(sorted_tok)
    blk_start = jnp.arange(n_rblk, dtype=jnp.int32) * MOE_BLOCK
    blk_e = jnp.minimum(jnp.searchsorted(pends, blk_start, side='right'), N_EXPERTS - 1)
    xin = hf[row_tok].reshape(n_rblk, MOE_BLOCK, D_)

    def expert_block(args):
        xb, e = args
        hb = (xb @ w1[e] + b1[e]).astype(jnp.float32)
        x_glu = jnp.minimum(hb[:, 0::2], SWIGLU_LIMIT)
        x_lin = jnp.clip(hb[:, 1::2], -SWIGLU_LIMIT, SWIGLU_LIMIT)
        act = x_glu * jax.nn.sigmoid(SWIGLU_ALPHA * x_glu) * (x_lin + 1.0)
        return act.astype(xb.dtype) @ w2[e] + b2[e]

    y = lax.map(expert_block, (xin, blk_e)).reshape(n_rows, D_)
    contrib = y[dest].astype(jnp.float32) * sorted_gate[:, None]
    out = jax.ops.segment_sum(contrib, sorted_tok, num_segments=T)
    return out.reshape(B_, S_, D_).astype(h.dtype)


def setup_inputs(seed: int = 0) -> dict:
    key = jax.random.key(seed)
    ks = jax.random.split(key, 20)
    nrm = jax.random.normal
    d_in = D_MODEL ** -0.5
    return {
        "x": nrm(ks[0], (BATCH, SEQ, D_MODEL)),
        "c": nrm(ks[1], (BATCH, D_MODEL)),
        "positions": jnp.broadcast_to(jnp.arange(SEQ, dtype=jnp.int32), (BATCH, SEQ)),
        "w_ada": nrm(ks[2], (DEPTH, D_MODEL, 6 * D_MODEL)) * (0.2 * d_in),
        "b_ada": nrm(ks[3], (DEPTH, 6 * D_MODEL)) * 0.02,
        "w_in": nrm(ks[4], (DEPTH, D_MODEL, IN_COLS)) * d_in,
        "hgrn_lb": 1.0 + 0.1 * nrm(ks[5], (DEPTH + 1, HG_WIDTH)),
        "gnorm_w": 1.0 + 0.1 * nrm(ks[6], (DEPTH, HG_WIDTH)),
        "w_o": nrm(ks[7], (DEPTH, D_MIX, D_MODEL)) * (D_MIX ** -0.5 * BETA_DEEPNORM),
        "ln1_g": 1.0 + 0.1 * nrm(ks[8], (DEPTH, D_MODEL)),
        "ln1_b": 0.02 * nrm(ks[9], (DEPTH, D_MODEL)),
        "router_w": nrm(ks[10], (DEPTH, D_MODEL, N_EXPERTS)) * d_in,
        "router_b": 0.01 * nrm(ks[11], (DEPTH, N_EXPERTS)),
        "w1": nrm(ks[12], (DEPTH, N_EXPERTS, D_MODEL, 2 * D_FF_EXPERT)) * d_in,
        "b1": 0.02 * nrm(ks[13], (DEPTH, N_EXPERTS, 2 * D_FF_EXPERT)),
        "w2": nrm(ks[14], (DEPTH, N_EXPERTS, D_FF_EXPERT, D_MODEL)) * (D_FF_EXPERT ** -0.5 * BETA_DEEPNORM),
        "b2": 0.02 * nrm(ks[15], (DEPTH, N_EXPERTS, D_MODEL)),
        "ln2_g": 1.0 + 0.1 * nrm(ks[16], (DEPTH, D_MODEL)),
        "ln2_b": 0.02 * nrm(ks[17], (DEPTH, D_MODEL)),
    }


def reference(x, c, positions, w_ada, b_ada, w_in, hgrn_lb, gnorm_w, w_o, ln1_g, ln1_b,
              router_w, router_b, w1, b1, w2, b2, ln2_g, ln2_b):
    lb_all = jnp.cumsum(jax.nn.softmax(hgrn_lb.astype(jnp.float32), axis=0), axis=0)
    for l in range(DEPTH):
        mod = jax.nn.silu(c) @ w_ada[l] + b_ada[l]
        sh_a, sc_a, gt_a, sh_f, sc_f, gt_f = [m[:, None, :] for m in jnp.split(mod, 6, axis=-1)]
        h = x * (1.0 + sc_a) + sh_a
        mix = hybrid_mixer(h, positions, w_in[l], lb_all[l], gnorm_w[l], w_o[l])
        x = layer_norm(ALPHA_DEEPNORM * x + (1.0 + gt_a) * mix, ln1_g[l], ln1_b[l])
        h = x * (1.0 + sc_f) + sh_f
        ff = moe_ffn(h, router_w[l], router_b[l], w1[l], b1[l], w2[l], b2[l])
        x = layer_norm(ALPHA_DEEPNORM * x + (1.0 + gt_f) * ff, ln2_g[l], ln2_b[l])
    return x
```

```cpp
#include <hip/hip_runtime.h>
#include <cstdio>
#include <cstdint>
__device__ __forceinline__ int fresh_lane() { int l; asm volatile("v_mbcnt_lo_u32_b32 %0, -1, 0\n\tv_mbcnt_hi_u32_b32 %0, -1, %0" : "=v"(l)); return l; }
__device__ __forceinline__ int wave_id() { return __builtin_amdgcn_readfirstlane(threadIdx.x >> 6); }
namespace pg8 {
#define PG8_LAS __attribute__((address_space(3)))
typedef unsigned short bf16_t;
typedef short bf16x8 __attribute__((ext_vector_type(8)));
typedef float f32x4 __attribute__((ext_vector_type(4)));
typedef unsigned u32x4 __attribute__((ext_vector_type(4)));
constexpr int ROWSLOT_OFF = 131072 + 4096;
constexpr int BM = 256, BK = 64, HALF = 128, HTB = HALF * BK * 2  , STAGE_BYTES = 8 * HTB, NXCD = 8, WGM = 8;

__host__ __device__ __forceinline__ int lds_byte(int r, int c) { const int st = (r >> 4) * 2 + (c >> 5), rr = r & 15, cc = c & 31, ob = rr * 64 + cc * 2; return st * 1024 + (ob ^ (((ob >> 9) & 1) << 5)); }
__host__ __device__ __forceinline__ void stage_rc(int b, int& R, int& C) { const int st = b / 1024, sb = b % 1024, swz = sb ^ (((sb >> 9) & 1) << 5); R = (st >> 1) * 16 + swz / 64; C = (st & 1) * 32 + (swz % 64) / 2; }
__host__ __device__ __forceinline__ int perm32(int rho) { const int n = rho >> 4, i = rho & 15; return 8 * (i >> 2) + 4 * n + (i & 3); }

struct Unit { int pm, pn, pb; };
struct Gemm { const bf16_t* A; const bf16_t* Bt; int M, N, K; const int* rowtok; };

struct StaticOrder {
    int nM, nN, nwg, G, c;
    __host__ __device__ void init(int M, int N, int G_, int c_) { nM = M / BM; nN = N / BM; nwg = nM * nN; G = G_; c = c_; }
    __host__ __device__ bool next(int i, Unit& u) const {
        const long L = (long)i * G + c; if (L >= nwg) return false;
        int wgid = (int)L; { const int q = nwg / NXCD, r = nwg % NXCD, xcd = wgid % NXCD, off = wgid / NXCD; wgid = (xcd < r ? xcd * (q + 1) : r * (q + 1) + (xcd - r) * q) + off; }
        const int nig = WGM * nN, gid = wgid / nig, fm = gid * WGM, gsz = (nM - fm) < WGM ? (nM - fm) : WGM;
        u.pm = fm + ((wgid % nig) % gsz); u.pn = (wgid % nig) / gsz; u.pb = u.pn; return true;
    }
    __device__ __forceinline__ void a_ready(const Unit&) const {}
    __device__ __forceinline__ void done(const Unit&) const {}
};

typedef int i32x4 __attribute__((ext_vector_type(4)));
typedef int i32x8 __attribute__((ext_vector_type(8)));
__device__ __forceinline__ i32x8 cat_i8(bf16x8 a, bf16x8 b) { return __builtin_shufflevector(__builtin_bit_cast(i32x4, a), __builtin_bit_cast(i32x4, b), 0, 1, 2, 3, 4, 5, 6, 7); }
__device__ __forceinline__ unsigned cvt_pk_bf16(float lo, float hi) { unsigned r; asm volatile("v_cvt_pk_bf16_f32 %0, %1, %2" : "=v"(r) : "v"(lo), "v"(hi)); return r; }

struct EpiStoreBf16 {
    static constexpr bool PERM = true, AFTER_DRAIN = false;
    bf16_t* O; int ldc;
    __device__ __forceinline__ void operator()(const f32x4 (&acc)[2][2][4][2], const Unit& u, int wr, int wc, int fr, int fq) const {
        const int row0 = u.pm * BM + wr * 64 + fr, col0 = u.pn * BM + wc * 32 + 8 * fq;
#pragma unroll
        for (int ai = 0; ai < 2; ++ai)
#pragma unroll
            for (int m = 0; m < 4; ++m) { bf16_t* rowp = O + (size_t)(row0 + ai * HALF + m * 16) * ldc + col0;
#pragma unroll
                for (int bj = 0; bj < 2; ++bj) { const f32x4 v0 = acc[ai][bj][m][0], v1 = acc[ai][bj][m][1];
                    u32x4 w; w.x = cvt_pk_bf16(v0[0], v0[1]); w.y = cvt_pk_bf16(v0[2], v0[3]); w.z = cvt_pk_bf16(v1[0], v1[1]); w.w = cvt_pk_bf16(v1[2], v1[3]);
                    *(u32x4*)(rowp + bj * HALF) = w; } }
    }
};
struct EpiProj {
    static constexpr bool PERM = true, AFTER_DRAIN = false;
    bf16_t* O; int ldc; const float* tab;
    __device__ __forceinline__ void operator()(const f32x4 (&acc)[2][2][4][2], const Unit& u, int wr, int wc, int fr, int fq) const {
        const int row0 = u.pm * BM + wr * 64 + fr, col0 = u.pn * BM + wc * 32 + 8 * fq;
        const bool rot = (u.pn < 8) && ((wc & 1) == 0); const float qs = (u.pn < 4) ? 0.18033688011112042f : 1.0f;
#pragma unroll
        for (int ai = 0; ai < 2; ++ai)
#pragma unroll
            for (int m = 0; m < 4; ++m) { const int row = row0 + ai * HALF + m * 16; bf16_t* rowp = O + (size_t)row * ldc + col0;
                f32x4 c0 = (f32x4){1.f, 1.f, 1.f, 1.f}, c1 = c0, s0 = (f32x4){0.f, 0.f, 0.f, 0.f}, s1 = s0;
                if (rot && fq < 2) { const float* tb = tab + (size_t)row * 16; c0 = *(const f32x4*)tb; c1 = *(const f32x4*)(tb + 4); s0 = *(const f32x4*)(tb + 8); s1 = *(const f32x4*)(tb + 12); if (fq == 0) { s0 = -s0; s1 = -s1; } }
#pragma unroll
                for (int bj = 0; bj < 2; ++bj) { f32x4 v0 = acc[ai][bj][m][0], v1 = acc[ai][bj][m][1];
                    if (rot) { f32x4 p0, p1;
#pragma unroll
                        for (int e = 0; e < 4; ++e) { p0[e] = __shfl_xor(v0[e], 16); p1[e] = __shfl_xor(v1[e], 16); }
                        v0 = v0 * c0 + p0 * s0; v1 = v1 * c1 + p1 * s1; }
                    v0 = v0 * qs; v1 = v1 * qs;
                    u32x4 w; w.x = cvt_pk_bf16(v0[0], v0[1]); w.y = cvt_pk_bf16(v0[2], v0[3]); w.z = cvt_pk_bf16(v1[0], v1[1]); w.w = cvt_pk_bf16(v1[2], v1[3]);
                    *(u32x4*)(rowp + bj * HALF) = w; }
                asm volatile("" ::: "memory"); }
    }
};
struct EpiSwiGLU {
    static constexpr bool PERM = true, AFTER_DRAIN = false;
    unsigned char* ACT; const float* b1p; float wscale;
    __device__ __forceinline__ void operator()(const f32x4 (&acc)[2][2][4][2], const Unit& u, int wr, int wc, int fr, int fq) const {
        const int row0 = u.pm * BM + wr * 64 + fr, hc0 = u.pn * HALF + wc * 32 + 8 * fq;
        const float* bp = b1p + (size_t)u.pb * BM + wc * 32 + 8 * fq;
        f32x4 bg[2], bl[2];
#pragma unroll
        for (int n = 0; n < 2; ++n) { bg[n] = *(const f32x4*)(bp + 4 * n); bl[n] = *(const f32x4*)(bp + HALF + 4 * n); }
#pragma unroll
        for (int ai = 0; ai < 2; ++ai)
#pragma unroll
            for (int m = 0; m < 4; ++m) { unsigned char* rowp = ACT + (size_t)(row0 + ai * HALF + m * 16) * 2048 + hc0; float r[8];
#pragma unroll
                for (int n = 0; n < 2; ++n) { const f32x4 g = acc[ai][0][m][n] * wscale + bg[n], l = acc[ai][1][m][n] * wscale + bl[n];
#pragma unroll
                    for (int j = 0; j < 4; ++j) { const float xg = fminf(g[j], 7.0f), xl = fminf(fmaxf(l[j], -7.0f), 7.0f);
                        r[4 * n + j] = xg * __builtin_amdgcn_rcpf(1.0f + __expf(-1.702f * xg)) * (xl + 1.0f); } }
                unsigned w0 = 0u, w1 = 0u;
                w0 = __builtin_amdgcn_cvt_pk_fp8_f32(r[0], r[1], w0, false); w0 = __builtin_amdgcn_cvt_pk_fp8_f32(r[2], r[3], w0, true);
                w1 = __builtin_amdgcn_cvt_pk_fp8_f32(r[4], r[5], w1, false); w1 = __builtin_amdgcn_cvt_pk_fp8_f32(r[6], r[7], w1, true);
                typedef unsigned u32x2 __attribute__((ext_vector_type(2))); *(u32x2*)rowp = (u32x2){w0, w1}; }
    }
};
struct EpiMoeOut {
    static constexpr bool PERM = true, AFTER_DRAIN = false;
    unsigned char* Y; const float* b2; const float* rgate; float wscale;
    __device__ __forceinline__ void operator()(const f32x4 (&acc)[2][2][4][2], const Unit& u, int wr, int wc, int fr, int fq) const {
        const int row0 = u.pm * BM + wr * 64 + fr, col0 = u.pn * BM + wc * 32 + 8 * fq;
        const float* bp = b2 + (size_t)(u.pb >> 3) * 2048 + col0;
        f32x4 bv[2][2];
#pragma unroll
        for (int bj = 0; bj < 2; ++bj)
#pragma unroll
            for (int n = 0; n < 2; ++n) bv[bj][n] = *(const f32x4*)(bp + bj * HALF + 4 * n);
#pragma unroll
        for (int ai = 0; ai < 2; ++ai)
#pragma unroll
            for (int m = 0; m < 4; ++m) { const int row = row0 + ai * HALF + m * 16; const float gt = rgate[row]; unsigned char* rowp = Y + (size_t)row * 2048 + col0;
#pragma unroll
                for (int bj = 0; bj < 2; ++bj) { const f32x4 v0 = (acc[ai][bj][m][0] * wscale + bv[bj][0]) * gt, v1 = (acc[ai][bj][m][1] * wscale + bv[bj][1]) * gt;
                    unsigned w0 = 0u, w1 = 0u; w0 = __builtin_amdgcn_cvt_pk_fp8_f32(v0[0], v0[1], w0, false); w0 = __builtin_amdgcn_cvt_pk_fp8_f32(v0[2], v0[3], w0, true);
                    w1 = __builtin_amdgcn_cvt_pk_fp8_f32(v1[0], v1[1], w1, false); w1 = __builtin_amdgcn_cvt_pk_fp8_f32(v1[2], v1[3], w1, true);
                    typedef unsigned u32x2 __attribute__((ext_vector_type(2))); *(u32x2*)(rowp + bj * HALF) = (u32x2){w0, w1}; } }
    }
};
struct MoeOrder : StaticOrder {
    const PG8_LAS int* tile_e;
    __device__ __forceinline__ bool next(int i, Unit& u) const { if (!StaticOrder::next(i, u)) return false; u.pb = __builtin_amdgcn_readfirstlane(tile_e[u.pm]) * nN + u.pn; return true; }
};
template <class Epi, class Sched, bool ALIGN_EPI = false, bool SP2 = false, bool F8 = false, bool GATHER = false>
__device__ __forceinline__ void gemm_phase(PG8_LAS unsigned char* lds, const Gemm g, const Sched& S, const Epi& E, const int wave_in) {
    const int tid_ = wave_in * 64 + fresh_lane();
    const int tid = tid_, wid = __builtin_amdgcn_readfirstlane(tid >> 6), lane = tid & 63, wr = wid >> 2, wc = wid & 3, fr = lane & 15, fq = lane >> 4;
    const int K = g.K, nt = K / BK;
    unsigned voffA0, voffB0;
    { int R, C; stage_rc(tid * 16, R, C); const int Rb = Epi::PERM ? ((R & ~31) + perm32(R & 31)) : R; voffA0 = (unsigned)(R * K + C) * 2u; voffB0 = (unsigned)(Rb * K + C) * 2u; }
    const size_t pdelta = (size_t)64 * K * 2;
    const size_t kstep = (size_t)(BK * 2);
    const size_t hstep = (size_t)HALF * K * 2;
    const size_t tstep = 2 * hstep;
    const unsigned ldsw = (unsigned)wid * 1024u, lds0 = (unsigned)(uintptr_t)lds;
    const int aoff = lds_byte(wr * 64 + fr, fq * 8), boff = lds_byte(wc * 32 + fr, fq * 8);
#define PG8_SA(b, h) (((b) * 2 + (h)) * HTB)
#define PG8_SB(b, h) ((4 + (b) * 2 + (h)) * HTB)
#define PG8_STAGE1(bufoff, i_, gbase, v_) do { unsigned _keep; \
        asm volatile("s_mov_b32 %0, m0\n\ts_mov_b32 m0, %3\n\ts_nop 0\n\tglobal_load_lds_dwordx4 %1, %2\n\ts_mov_b32 m0, %0" : "=&s"(_keep) \
            : "v"(v_), "s"((const char*)(gbase)), "s"(lds0 + (unsigned)((bufoff) + (i_) * 8192) + ldsw) : "memory"); } while (0)
#define PG8_STAGE(bufoff, gbase, v0_) do { PG8_STAGE1(bufoff, 0, gbase, v0_); PG8_STAGE1(bufoff, 1, (const char*)(gbase) + pdelta, v0_); } while (0)
#define PG8_STAGE_A(bufoff, ptr, h) do { if constexpr (GATHER) { PG8_STAGE1(bufoff, 0, ptr, vAc[h][0]); PG8_STAGE1(bufoff, 1, ptr, vAc[h][1]); } \
        else { PG8_STAGE(bufoff, (ptr) + (h) * hstep, voffA0); } } while (0)
#define PG8_ROWS(u, v) do { _Pragma("unroll") for (int _h = 0; _h < 2; ++_h) _Pragma("unroll") for (int _i = 0; _i < 2; ++_i) { int R_, C_; stage_rc(tid * 16 + _i * 8192, R_, C_); \
        v[_h][_i] = (unsigned)g.rowtok[(u).pm * BM + _h * HALF + R_] * (unsigned)(K * 2) + (unsigned)(C_ * 2); } } while (0)
#define PG8_LDA(dst, b, h) do { _Pragma("unroll") for (int m = 0; m < 4; ++m) { if constexpr (F8) dst##8[m] = cat_i8(*(const PG8_LAS bf16x8*)(lds + PG8_SA(b, h) + aoff + m * 2048), *(const PG8_LAS bf16x8*)(lds + PG8_SA(b, h) + aoff + m * 2048 + 1024)); \
        else { _Pragma("unroll") for (int k = 0; k < 2; ++k) dst[m][k] = *(const PG8_LAS bf16x8*)(lds + PG8_SA(b, h) + aoff + m * 2048 + k * 1024); } } } while (0)
#define PG8_LDB(dst, b, h) do { _Pragma("unroll") for (int n = 0; n < 2; ++n) { if constexpr (F8) dst##8[n] = cat_i8(*(const PG8_LAS bf16x8*)(lds + PG8_SB(b, h) + boff + n * 2048), *(const PG8_LAS bf16x8*)(lds + PG8_SB(b, h) + boff + n * 2048 + 1024)); \
        else { _Pragma("unroll") for (int k = 0; k < 2; ++k) dst[n][k] = *(const PG8_LAS bf16x8*)(lds + PG8_SB(b, h) + boff + n * 2048 + k * 1024); } } } while (0)
#define PG8_MMA(ai, bj, At, Bt) do { __builtin_amdgcn_s_setprio(1); _Pragma("unroll") for (int m = 0; m < 4; ++m) _Pragma("unroll") for (int n = 0; n < 2; ++n) { \
        if constexpr (F8) { acc[ai][bj][m][n] = __builtin_amdgcn_mfma_scale_f32_16x16x128_f8f6f4(Bt##8[n], At##8[m], acc[ai][bj][m][n], 0, 0, 0, 0, 0, 0); } \
        else { _Pragma("unroll") for (int k = 0; k < 2; ++k) acc[ai][bj][m][n] = __builtin_amdgcn_mfma_f32_16x16x32_bf16(Bt[n][k], At[m][k], acc[ai][bj][m][n], 0, 0, 0); } } \
        __builtin_amdgcn_s_setprio(0); } while (0)
#define PG8_WAIT_V(n) asm volatile("s_waitcnt vmcnt(" #n ")" ::: "memory")
#define PG8_WAIT_L(n) asm volatile("s_waitcnt lgkmcnt(" #n ")" ::: "memory")
#define PG8_BAR __builtin_amdgcn_s_barrier()
#define PG8_SCHED __builtin_amdgcn_sched_barrier(0)
    Unit cur, nxt; int ui = 0;
    if (!S.next(0, cur)) return;
    f32x4 acc[2][2][4][2];
#pragma unroll
    for (int a = 0; a < 2; ++a)
#pragma unroll
        for (int b = 0; b < 2; ++b)
#pragma unroll
            for (int m = 0; m < 4; ++m)
#pragma unroll
                for (int n = 0; n < 2; ++n) acc[a][b][m][n] = (f32x4){0.f, 0.f, 0.f, 0.f};
    bf16x8 At[4][2], B0[2][2], B1[2][2]; i32x8 At8[4], B08[2], B18[2];
    const char* cA = (const char*)g.A + (GATHER ? (size_t)0 : (size_t)cur.pm * tstep); const char* cB = (const char*)g.Bt + (size_t)cur.pb * tstep;
    unsigned vAc[2][2];
    PG8_LAS u32x4* const rowslot = (PG8_LAS u32x4*)(lds + ROWSLOT_OFF) + tid;
    if constexpr (GATHER) { PG8_ROWS(cur, vAc); }
    S.a_ready(cur);
    if constexpr (SP2) {
        PG8_STAGE(PG8_SB(0, 0), cB, voffB0); PG8_STAGE(PG8_SB(0, 1), cB + hstep, voffB0); PG8_STAGE_A(PG8_SA(0, 0), cA, 0); PG8_STAGE_A(PG8_SA(0, 1), cA, 1);
        if (wr == 1) PG8_BAR;
        PG8_WAIT_V(2); PG8_BAR;
        PG8_STAGE(PG8_SB(1, 0), cB + kstep, voffB0); PG8_STAGE_A(PG8_SA(1, 0), cA + kstep, 0); PG8_STAGE(PG8_SB(1, 1), cB + hstep + kstep, voffB0);
        PG8_WAIT_V(6); PG8_BAR;
    } else {
        PG8_STAGE(PG8_SB(0, 0), cB, voffB0); PG8_STAGE_A(PG8_SA(0, 0), cA, 0); PG8_STAGE(PG8_SB(0, 1), cB + hstep, voffB0); PG8_STAGE_A(PG8_SA(0, 1), cA, 1);
        if (wr == 1) PG8_BAR;
        PG8_WAIT_V(4); PG8_BAR;
        PG8_STAGE(PG8_SB(1, 0), cB + kstep, voffB0); PG8_STAGE_A(PG8_SA(1, 0), cA + kstep, 0); PG8_STAGE(PG8_SB(1, 1), cB + hstep + kstep, voffB0);
        PG8_WAIT_V(6); PG8_BAR;
    }
    for (;;) {
        const bool has_next = S.next(ui + 1, nxt);
        if constexpr (GATHER) { if (has_next) { unsigned vAn[2][2]; PG8_ROWS(nxt, vAn); *rowslot = (u32x4){vAn[0][0], vAn[0][1], vAn[1][0], vAn[1][1]}; } }
        const char* nA = has_next ? (const char*)g.A + (GATHER ? (size_t)0 : (size_t)nxt.pm * tstep) : (GATHER ? (const char*)g.A : cA); const char* nB = has_next ? (const char*)g.Bt + (size_t)nxt.pb * tstep : cB;
        for (int t = 0; t < nt; t += 2) {
            const bool last = (t == nt - 2);
            const char* a1 = cA + (size_t)(t + 1) * kstep;
            const char* a2 = last ? nA : cA + (size_t)(t + 2) * kstep; const char* b2 = last ? nB : cB + (size_t)(t + 2) * kstep;
            const char* a3 = a2 + kstep; const char* b3 = b2 + kstep;
            if (last && has_next) S.a_ready(nxt);
            const bool nx = last && has_next;
            if constexpr (SP2) {
            PG8_LDB(B0, 0, 0); PG8_LDB(B1, 0, 1); PG8_SCHED; PG8_LDA(At, 0, 0); PG8_STAGE_A(PG8_SA(1, 1), a1, 1);
            if constexpr (GATHER) { if (nx) { const u32x4 rv = *rowslot; vAc[0][0] = rv.x; vAc[0][1] = rv.y; vAc[1][0] = rv.z; vAc[1][1] = rv.w; } }
            PG8_WAIT_V(8); PG8_WAIT_L(0); PG8_BAR; PG8_MMA(0, 0, At, B0); PG8_MMA(0, 1, At, B1); PG8_BAR; PG8_SCHED;
            PG8_LDA(At, 0, 1); PG8_STAGE(PG8_SB(0, 0), b2, voffB0); PG8_STAGE(PG8_SB(0, 1), b2 + hstep, voffB0); PG8_STAGE_A(PG8_SA(0, 0), a2, 0);
            PG8_WAIT_V(8); PG8_WAIT_L(0); PG8_BAR; PG8_MMA(1, 0, At, B0); PG8_MMA(1, 1, At, B1); PG8_BAR; PG8_SCHED;
            PG8_LDB(B0, 1, 0); PG8_LDB(B1, 1, 1); PG8_SCHED; PG8_LDA(At, 1, 0); PG8_STAGE_A(PG8_SA(0, 1), a2, 1);
            PG8_WAIT_V(8); PG8_WAIT_L(0); PG8_BAR; PG8_MMA(0, 0, At, B0); PG8_MMA(0, 1, At, B1); PG8_BAR; PG8_SCHED;
            PG8_LDA(At, 1, 1); PG8_STAGE(PG8_SB(1, 0), b3, voffB0); PG8_STAGE(PG8_SB(1, 1), b3 + hstep, voffB0); PG8_STAGE_A(PG8_SA(1, 0), a3, 0);
            PG8_WAIT_V(8); PG8_WAIT_L(0); PG8_BAR; PG8_MMA(1, 0, At, B0); PG8_MMA(1, 1, At, B1); PG8_BAR; PG8_SCHED;
            } else {
            PG8_LDB(B0, 0, 0); PG8_SCHED; PG8_LDA(At, 0, 0); PG8_STAGE_A(PG8_SA(1, 1), a1, 1);
            if constexpr (GATHER) { if (nx) { const u32x4 rv = *rowslot; vAc[0][0] = rv.x; vAc[0][1] = rv.y; vAc[1][0] = rv.z; vAc[1][1] = rv.w; } }
            PG8_WAIT_L(8); PG8_BAR; PG8_WAIT_L(0); PG8_MMA(0, 0, At, B0); PG8_BAR; PG8_SCHED;
            PG8_LDB(B1, 0, 1); PG8_STAGE(PG8_SB(0, 0), b2, voffB0);
            PG8_BAR; PG8_WAIT_L(0); PG8_MMA(0, 1, At, B1); PG8_BAR;
            PG8_LDA(At, 0, 1); PG8_STAGE_A(PG8_SA(0, 0), a2, 0);
            PG8_BAR; PG8_WAIT_L(0); PG8_MMA(1, 0, At, B0); PG8_BAR; PG8_SCHED;
            PG8_STAGE(PG8_SB(0, 1), b2 + hstep, voffB0);
            PG8_WAIT_V(6); PG8_BAR; PG8_MMA(1, 1, At, B1); PG8_BAR;
            PG8_LDB(B0, 1, 0); PG8_SCHED; PG8_LDA(At, 1, 0); PG8_STAGE_A(PG8_SA(0, 1), a2, 1);
            PG8_WAIT_L(8); PG8_BAR; PG8_WAIT_L(0); PG8_MMA(0, 0, At, B0); PG8_BAR; PG8_SCHED;
            PG8_LDB(B1, 1, 1); PG8_STAGE(PG8_SB(1, 0), b3, voffB0);
            PG8_BAR; PG8_WAIT_L(0); PG8_MMA(0, 1, At, B1); PG8_BAR;
            PG8_LDA(At, 1, 1); PG8_STAGE_A(PG8_SA(1, 0), a3, 0);
            PG8_BAR; PG8_WAIT_L(0); PG8_MMA(1, 0, At, B0); PG8_BAR; PG8_SCHED;
            PG8_STAGE(PG8_SB(1, 1), b3 + hstep, voffB0);
            PG8_WAIT_V(6); PG8_BAR; PG8_MMA(1, 1, At, B1); PG8_BAR;
            }
        }
        if constexpr (ALIGN_EPI) { if (wr == 0) PG8_BAR; }
        if constexpr (!Epi::AFTER_DRAIN) { const int le = fresh_lane(); E(acc, cur, wr, wc, le & 15, le >> 4); S.done(cur); }
        if (!has_next) break;
#pragma unroll
        for (int a = 0; a < 2; ++a)
#pragma unroll
            for (int b = 0; b < 2; ++b)
#pragma unroll
                for (int m = 0; m < 4; ++m)
#pragma unroll
                    for (int n = 0; n < 2; ++n) acc[a][b][m][n] = (f32x4){0.f, 0.f, 0.f, 0.f};
        cur = nxt; cA = nA; cB = nB; ++ui;

        if constexpr (ALIGN_EPI) { if (wr == 1) PG8_BAR; }
    }
    PG8_WAIT_V(0);
    if constexpr (!ALIGN_EPI) { if (wr == 0) PG8_BAR; }
    PG8_BAR;
    if constexpr (Epi::AFTER_DRAIN) { E.fused(acc, cur, wr, wc, fr, fq, lds, wid, lane); S.done(cur); }
#undef PG8_SA
#undef PG8_SB
#undef PG8_STAGE
#undef PG8_LDA
#undef PG8_STAGE_A
#undef PG8_STAGE1
#undef PG8_ROWS
#undef PG8_LDB
#undef PG8_MMA
#undef PG8_WAIT_V
#undef PG8_WAIT_L
#undef PG8_BAR
#undef PG8_SCHED
}
}

constexpr int NB = 4, SEQ = 2048, DM = 2048, NTOK = NB * SEQ;
constexpr int NIN = 7168;
constexpr int NEXP = 32, FFE = 2048;
constexpr int MAXROWS = 40960;
constexpr float ALPHA_DN = 1.189207115002721f;
constexpr int NWAVES = 8;
constexpr size_t MiB = 1u << 20;
constexpr size_t WS_CTL = 0, CTL_ZERO_BYTES = 1 * MiB;
constexpr size_t WS_ROWTOK = 256 * 1024;
constexpr size_t WS_MOD = 1 * MiB, WS_TAB = 2 * MiB, WS_B1P = 3 * MiB, WS_ASG = 4 * MiB, WS_RGATE = 5 * MiB, WS_RWT = 6 * MiB;
constexpr size_t WS_WINT = 8 * MiB, WS_WOT = 36 * MiB, WS_W1T = 64 * MiB, WS_W2T = 576 * MiB;
constexpr size_t WS_H = 832 * MiB, WS_PROJ = 864 * MiB, WS_ORAW = 976 * MiB, WS_MIXED = 1008 * MiB, WS_MIXF = 1040 * MiB, WS_X1 = 1104 * MiB;
constexpr size_t WS_XG = 1168 * MiB, WS_ACT = 1328 * MiB, WS_Y = 1488 * MiB, WS_END = 1648 * MiB;
constexpr size_t WS_HIMG = WS_XG, WS_HSC = WS_XG + 64 * MiB;
constexpr size_t WS_OB = WS_ACT, WS_LSE = WS_ACT + 64 * MiB;
constexpr int CW_TMO = 0, CW_QUEUE = 32  , CW_CNT = 64  , CW_BAR = 4096, CW_BAR2 = 8192;
constexpr int RING_BYTES = 131072, LDSCTL_OFF = RING_BYTES, MISC_OFF = LDSCTL_OFF + 320, TAB_OFF = LDSCTL_OFF + 1024;
constexpr int LDS_BYTES = 147456;

#define GAS __attribute__((address_space(1)))
#define LAS __attribute__((address_space(3)))
typedef unsigned short bf16;
typedef unsigned v4u __attribute__((ext_vector_type(4)));
typedef unsigned v2u __attribute__((ext_vector_type(2)));
typedef float f32x4 __attribute__((ext_vector_type(4)));
typedef GAS unsigned gu32;
#define RLX_AGENT __ATOMIC_RELAXED, __HIP_MEMORY_SCOPE_AGENT
#define LDS_WAIT() asm volatile("s_waitcnt lgkmcnt(0)" ::: "memory")
#define VM_WAIT() asm volatile("s_waitcnt vmcnt(0)" ::: "memory")
__device__ __forceinline__ unsigned f2bf(float f) { unsigned u = __builtin_bit_cast(unsigned, f); return (u + 0x7fffu + ((u >> 16) & 1u)) >> 16; }
__device__ __forceinline__ unsigned pk2(float lo, float hi) { return f2bf(lo) | (f2bf(hi) << 16); }
__device__ __forceinline__ float bflo(unsigned w) { return __builtin_bit_cast(float, w << 16); }
__device__ __forceinline__ float bfhi(unsigned w) { return __builtin_bit_cast(float, w & 0xffff0000u); }
__device__ __forceinline__ f32x4 ldg4(const void* ubase, unsigned voff) { return *(const GAS f32x4*)((const GAS unsigned char*)ubase + voff); }
__device__ __forceinline__ void stg4(void* ubase, unsigned voff, f32x4 v) { *(GAS f32x4*)((GAS unsigned char*)ubase + voff) = v; }
__device__ __forceinline__ v2u ldg2(const void* ubase, unsigned voff) { return *(const GAS v2u*)((const GAS unsigned char*)ubase + voff); }
__device__ __forceinline__ float wave_sum(float v) {
#pragma unroll
    for (int o = 1; o < 64; o <<= 1) v += __shfl_xor(v, o);
    return v;
}
#define XB_TMO      128
#define XB_XCNT(j)  (256  + 64 * (j))
#define XB_XSUB(j)  (1280 + 64 * (j))
#define XB_XGEN(j)  (2304 + 64 * (j))
#define XB_TOP      3328
#define XB_TOPGEN   3392
#define XCD_BAR_WORDS 3456
#define XB_SPIN_CAP (1u << 18)

__device__ __forceinline__ unsigned xb_ld(unsigned* p)              { return __hip_atomic_load(p, __ATOMIC_RELAXED, __HIP_MEMORY_SCOPE_AGENT); }
__device__ __forceinline__ unsigned xb_add(unsigned* p, unsigned v) { return __hip_atomic_fetch_add(p, v, __ATOMIC_RELAXED, __HIP_MEMORY_SCOPE_AGENT); }
__device__ __forceinline__ unsigned xb_xcc_id() { return (unsigned)__builtin_amdgcn_s_getreg((3 << 11) | 20) & 0xFu; }
#define XB_SPIN(cond, bar) do { unsigned _sp = 0; while (cond) { __builtin_amdgcn_s_sleep(1); \
    if ((++_sp & 255u) == 0u) { if (xb_ld(&(bar)[XB_TMO])) break; if (_sp > XB_SPIN_CAP) { atomicAdd(&(bar)[XB_TMO], 1u); break; } } } } while (0)

struct XcdBarrier {
    int wave; unsigned G;
    unsigned* bar; unsigned x;
    volatile LAS unsigned* st;
};

__device__ __forceinline__ XcdBarrier xcd_barrier_post(unsigned* bar, volatile LAS unsigned* st, int wave, unsigned G) {
    XcdBarrier b; b.wave = wave; b.G = G; b.bar = bar; b.x = xb_xcc_id(); b.st = st;
    if (wave == 0 && fresh_lane() == 0) (void)xb_add(&bar[XB_XCNT(b.x)], 1u);
    return b;
}
__device__ __forceinline__ void xcd_barrier_complete(unsigned* bar, unsigned x, unsigned& nloc, unsigned& nx, const unsigned G) {
    unsigned sum, cnt, mine, sp = 0u;
    for (;;) {
        sum = 0u; cnt = 0u; mine = 0u;
#pragma unroll
        for (unsigned j = 0; j < 16; ++j) { const unsigned c = xb_ld(&bar[XB_XCNT(j)]); sum += c; cnt += (c > 0u) ? 1u : 0u; mine = (j == x) ? c : mine; }
        if (sum == G) break;
        __builtin_amdgcn_s_sleep(1);
        if ((++sp & 255u) == 0u) { if (xb_ld(&bar[XB_TMO])) break; if (sp > XB_SPIN_CAP) { atomicAdd(&bar[XB_TMO], 1u); break; } }
    }
    nloc = mine > 0u ? mine : 1u; nx = cnt > 0u ? cnt : 1u;
}

__device__ __forceinline__ void xcd_barrier(const XcdBarrier& b) {
    asm volatile("s_waitcnt vmcnt(0)" ::: "memory");
    __syncthreads();
    if (b.wave == 0 && fresh_lane() == 0) {
        unsigned* bar = b.bar;
        __builtin_amdgcn_s_waitcnt(0);
        unsigned nloc = b.st[0], nx = b.st[1];
        if (nloc == 0u) { xcd_barrier_complete(bar, b.x, nloc, nx, b.G); b.st[0] = nloc; b.st[1] = nx; }
        const unsigned old = xb_add(&bar[XB_XSUB(b.x)], 1u);
        const unsigned gen = old / nloc;
        if (old + 1u == (gen + 1u) * nloc) {
            __builtin_amdgcn_fence(__ATOMIC_RELEASE, "agent");
            asm volatile("s_waitcnt vmcnt(0)" ::: "memory");
            const unsigned og = xb_add(&bar[XB_TOP], 1u);
            const unsigned tg = og / nx;
            if (og + 1u == (tg + 1u) * nx) xb_add(&bar[XB_TOPGEN], 1u);
            else XB_SPIN(xb_ld(&bar[XB_TOPGEN]) == tg, bar);
            __builtin_amdgcn_fence(__ATOMIC_ACQUIRE, "agent");
            xb_add(&bar[XB_XGEN(b.x)], 1u);
            asm volatile("s_waitcnt vmcnt(0)" ::: "memory");
        } else {
            XB_SPIN(xb_ld(&bar[XB_XGEN(b.x)]) == gen, bar);
            __builtin_amdgcn_fence(__ATOMIC_ACQUIRE, "agent");
            asm volatile("s_waitcnt vmcnt(0)" ::: "memory");
        }
    }
    __syncthreads();
}

struct Args {
    const float* x; const float* c; const int* pos; const float* w_ada; const float* b_ada; const float* w_in; const float* hgrn_lb; const float* gnorm_w;
    const float* w_o; const float* ln1_g; const float* ln1_b; const float* router_w; const float* router_b; const float* w1; const float* b1; const float* w2;
    const float* b2; const float* ln2_g; const float* ln2_b; float* out; unsigned char* ws;
};

__device__ __forceinline__ void p0_mod(const Args& a, LAS unsigned char* lds, int tid, int blk, int nblk) {
    LAS float* sc = (LAS float*)lds;
    LAS float* part = (LAS float*)(lds + 32768);
    for (int i = tid; i < NB * DM; i += 512) { const float v = a.c[i]; sc[i] = v / (1.0f + __expf(-v)); }
    __syncthreads();
    for (int bx = blk; bx < 192; bx += nblk) {
        __syncthreads();
        const int cg = tid & 15, ks = tid >> 4;
        const float* wp = a.w_ada + (size_t)(ks * 64) * 12288 + bx * 64 + cg * 4;
        f32x4 acc[4];
#pragma unroll
        for (int b = 0; b < 4; ++b) acc[b] = (f32x4){0.f, 0.f, 0.f, 0.f};
#pragma unroll 8
        for (int kk = 0; kk < 64; ++kk) { const f32x4 w = *(const f32x4*)(wp + (size_t)kk * 12288);
#pragma unroll
            for (int b = 0; b < 4; ++b) acc[b] += w * sc[b * DM + ks * 64 + kk]; }
#pragma unroll
        for (int b = 0; b < 4; ++b) *(LAS f32x4*)(part + (ks * 4 + b) * 64 + cg * 4) = acc[b];
        __syncthreads();
        if (tid < 256) { const int b = tid >> 6, col = tid & 63; float s = a.b_ada[bx * 64 + col];
            for (int k = 0; k < 32; ++k) s += part[(k * 4 + b) * 64 + col];
            ((float*)(a.ws + WS_MOD))[b * 12288 + bx * 64 + col] = s; }
    }
    __syncthreads();
}
struct TrIt { const float* src; bf16* dst; int N; int nn0; int perm; };
__device__ __forceinline__ TrIt tr_decode(const Args& a, int it, int lane) {
    constexpr int I_IN = 32 * (NIN / 32), I_O = 32 * (DM / 32), I_1 = 32 * (4096 / 32), I_2 = 32 * (2048 / 32);
    const int nq = lane & 7, ko = lane >> 3; int r = it, nblk; const float* W; bf16* WT; TrIt t; t.perm = 0;
    if (r < I_IN) { W = a.w_in; t.N = NIN; WT = (bf16*)(a.ws + WS_WINT); nblk = NIN / 32; }
    else if ((r -= I_IN) < I_O) { W = a.w_o; t.N = DM; WT = (bf16*)(a.ws + WS_WOT); nblk = DM / 32; }
    else if ((r -= I_O) < NEXP * I_1) { const int e = r / I_1; r -= e * I_1; W = a.w1 + (size_t)e * 2048 * 4096; t.N = 4096; WT = (bf16*)(a.ws + WS_W1T) + (size_t)e * 4096 * 2048; nblk = 128; t.perm = 1; }
    else { r -= NEXP * I_1; const int e = r / I_2; r -= e * I_2; W = a.w2 + (size_t)e * 2048 * 2048; t.N = 2048; WT = (bf16*)(a.ws + WS_W2T) + (size_t)e * 2048 * 2048; nblk = 64; }
    const int kb = r / nblk, nb = r - kb * nblk;
    t.nn0 = 32 * nb + 4 * nq; t.src = W + (size_t)(64 * kb + 8 * ko) * t.N + t.nn0; t.dst = WT + 64 * kb + 8 * ko;
    return t;
}
constexpr int TR_ITEMS_DENSE = 32 * (NIN / 32) + 32 * (DM / 32);
__device__ __forceinline__ void tr_load(const TrIt& t, f32x4 (&r)[8]) {
#pragma unroll
    for (int i = 0; i < 8; ++i) r[i] = __builtin_nontemporal_load((const GAS f32x4*)(t.src + (size_t)i * t.N));
}
__device__ __forceinline__ void tr_store(const TrIt& t, const f32x4 (&r)[8]) {
#pragma unroll
    for (int j = 0; j < 4; ++j) { const int nn = t.nn0 + j; const int drow = t.perm ? ((((nn >> 1) >> 7) << 8) + ((nn >> 1) & 127) + ((nn & 1) << 7)) : nn;
        v4u o; o.x = pg8::cvt_pk_bf16(r[0][j], r[1][j]); o.y = pg8::cvt_pk_bf16(r[2][j], r[3][j]); o.z = pg8::cvt_pk_bf16(r[4][j], r[5][j]); o.w = pg8::cvt_pk_bf16(r[6][j], r[7][j]);
        *(GAS v4u*)(t.dst + (size_t)drow * 2048) = o; }
}
__device__ __forceinline__ void p0_weights(const Args& a, int gw, int NGW, int lane, const int it0, const int NITEMS) {
    f32x4 r0[8], r1[8], r2[8], r3[8]; TrIt t0, t1, t2, t3; int it = it0 + gw;
    if (it < NITEMS) { t0 = tr_decode(a, it, lane); tr_load(t0, r0); }
    if (it + NGW < NITEMS) { t1 = tr_decode(a, it + NGW, lane); tr_load(t1, r1); }
    if (it + 2 * NGW < NITEMS) { t2 = tr_decode(a, it + 2 * NGW, lane); tr_load(t2, r2); }
    if (it + 3 * NGW < NITEMS) { t3 = tr_decode(a, it + 3 * NGW, lane); tr_load(t3, r3); }
    while (it < NITEMS) {
        tr_store(t0, r0); if (it + 4 * NGW < NITEMS) { t0 = tr_decode(a, it + 4 * NGW, lane); tr_load(t0, r0); }
        if (it + NGW < NITEMS) { tr_store(t1, r1); if (it + 5 * NGW < NITEMS) { t1 = tr_decode(a, it + 5 * NGW, lane); tr_load(t1, r1); } }
        if (it + 2 * NGW < NITEMS) { tr_store(t2, r2); if (it + 6 * NGW < NITEMS) { t2 = tr_decode(a, it + 6 * NGW, lane); tr_load(t2, r2); } }
        if (it + 3 * NGW < NITEMS) { tr_store(t3, r3); if (it + 7 * NGW < NITEMS) { t3 = tr_decode(a, it + 7 * NGW, lane); tr_load(t3, r3); } }
        it += 4 * NGW; }
}
constexpr float W8_SCALE = 64.0f;
constexpr int TR8_I1 = 16 * (4096 / 32), TR8_I2 = 16 * (2048 / 32), TR8_ITEMS = NEXP * TR8_I1 + NEXP * TR8_I2;
constexpr int TR8_SPLIT = (int)(TR8_ITEMS * 1.0);
struct Tr8 { const float* src; unsigned char* dst; int N; int nn0; int perm; };
__device__ __forceinline__ Tr8 tr8_decode(const Args& a, int it, int lane) {
    const int nq = lane & 7, ko = lane >> 3; int r = it, nblk; const float* W; unsigned char* WT; Tr8 t;
    if (r < NEXP * TR8_I1) { const int e = r / TR8_I1; r -= e * TR8_I1; W = a.w1 + (size_t)e * 2048 * 4096; t.N = 4096; WT = a.ws + WS_W1T + (size_t)e * 4096 * 2048; nblk = 128; t.perm = 1; }
    else { r -= NEXP * TR8_I1; const int e = r / TR8_I2; r -= e * TR8_I2; W = a.w2 + (size_t)e * 2048 * 2048; t.N = 2048; WT = a.ws + WS_W2T + (size_t)e * 2048 * 2048; nblk = 64; t.perm = 0; }
    const int kb = r / nblk, nb = r - kb * nblk;
    t.nn0 = 32 * nb + 4 * nq; t.src = W + (size_t)(128 * kb + 16 * ko) * t.N + t.nn0; t.dst = WT + 128 * kb + 16 * ko;
    return t;
}
__device__ __forceinline__ void tr8_load(const Tr8& t, f32x4 (&r)[16]) {
#pragma unroll
    for (int i = 0; i < 16; ++i) r[i] = __builtin_nontemporal_load((const GAS f32x4*)(t.src + (size_t)i * t.N));
}
__device__ __forceinline__ void tr8_store(const Tr8& t, const f32x4 (&r)[16]) {
#pragma unroll
    for (int j = 0; j < 4; ++j) { const int nn = t.nn0 + j; const int drow = t.perm ? ((((nn >> 1) >> 7) << 8) + ((nn >> 1) & 127) + ((nn & 1) << 7)) : nn;
        unsigned d[4];
#pragma unroll
        for (int q = 0; q < 4; ++q) { unsigned w = 0u; w = __builtin_amdgcn_cvt_pk_fp8_f32(r[4 * q][j] * W8_SCALE, r[4 * q + 1][j] * W8_SCALE, w, false);
            w = __builtin_amdgcn_cvt_pk_fp8_f32(r[4 * q + 2][j] * W8_SCALE, r[4 * q + 3][j] * W8_SCALE, w, true); d[q] = w; }
        v4u o; o.x = d[0]; o.y = d[1]; o.z = d[2]; o.w = d[3];
        *(GAS v4u*)(t.dst + (size_t)drow * 2048) = o; }
}
__device__ __forceinline__ void conv8_weights(const Args& a, int gw, int NGW, int lane, const int it0, const int NITEMS) {
    f32x4 r0[16], r1[16]; Tr8 t0, t1; int it = it0 + gw;
    if (it < NITEMS) { t0 = tr8_decode(a, it, lane); tr8_load(t0, r0); }
    if (it + NGW < NITEMS) { t1 = tr8_decode(a, it + NGW, lane); tr8_load(t1, r1); }
    while (it < NITEMS) {
        tr8_store(t0, r0); if (it + 2 * NGW < NITEMS) { t0 = tr8_decode(a, it + 2 * NGW, lane); tr8_load(t0, r0); }
        if (it + NGW < NITEMS) { tr8_store(t1, r1); if (it + 3 * NGW < NITEMS) { t1 = tr8_decode(a, it + 3 * NGW, lane); tr8_load(t1, r1); } }
        it += 2 * NGW; }
}
__device__ __forceinline__ void conv8_weights_dyn(const Args& a, int lane, const int NITEMS) {
    gu32* q = (gu32*)(a.ws + WS_CTL) + CW_QUEUE;
    f32x4 r0[16], r1[16]; Tr8 t0, t1; t0.src = nullptr; t1.src = nullptr;
    unsigned gv = 0u, gn = 0u;
    if (lane == 0) gv = __hip_atomic_fetch_add(q, 4u, RLX_AGENT);
    if (lane == 0) gn = __hip_atomic_fetch_add(q, 4u, RLX_AGENT);
    int cb = __builtin_amdgcn_readfirstlane((int)gv), k = 0;
    int i0 = cb + 0, i1 = cb + 1; k = 2;
    if (i0 < NITEMS) { t0 = tr8_decode(a, i0, lane); tr8_load(t0, r0); }
    if (i1 < NITEMS) { t1 = tr8_decode(a, i1, lane); tr8_load(t1, r1); }
    while (i0 < NITEMS || i1 < NITEMS) {
        if (i0 < NITEMS) tr8_store(t0, r0);
        if (k == 4) { cb = __builtin_amdgcn_readfirstlane((int)gn); k = 0; if (lane == 0) gn = __hip_atomic_fetch_add(q, 4u, RLX_AGENT); }
        i0 = cb + k++; if (i0 < NITEMS) { t0 = tr8_decode(a, i0, lane); tr8_load(t0, r0); }
        if (i1 < NITEMS) tr8_store(t1, r1);
        if (k == 4) { cb = __builtin_amdgcn_readfirstlane((int)gn); k = 0; if (lane == 0) gn = __hip_atomic_fetch_add(q, 4u, RLX_AGENT); }
        i1 = cb + k++; if (i1 < NITEMS) { t1 = tr8_decode(a, i1, lane); tr8_load(t1, r1); }
    }
}
__device__ __forceinline__ void p0_small(const Args& a, int gw, int NGW, int lane) {
    float* b1p = (float*)(a.ws + WS_B1P);
    for (int i = gw * 64 + lane; i < NEXP * 4096; i += NGW * 64) { const int e = i >> 12, nn = i & 4095; const int drow = (((nn >> 1) >> 7) << 8) + ((nn >> 1) & 127) + ((nn & 1) << 7); b1p[e * 4096 + drow] = a.b1[i]; }
    bf16* rwh = (bf16*)(a.ws + WS_RWT); bf16* rwl = rwh + NEXP * DM;
    for (int i = gw * 64 + lane; i < NEXP * DM; i += NGW * 64) { const int e = i >> 11, col = i & 2047; const float w = a.router_w[col * 32 + e]; const unsigned hb = f2bf(w); rwh[i] = (bf16)hb; rwl[i] = (bf16)f2bf(w - __builtin_bit_cast(float, hb << 16)); }
}

__device__ __forceinline__ void p1_h(const Args& a, int gw, int NGW, int lane) {
    const float* MOD = (const float*)(a.ws + WS_MOD); bf16* H = (bf16*)(a.ws + WS_H);
    const unsigned vo = (unsigned)lane * 16u, vh = (unsigned)lane * 8u;
    for (int row = gw; row < NTOK; row += NGW) { const int b = row >> 11; const float* mb = MOD + b * 12288; const float* xr = a.x + (size_t)row * DM; bf16* hr = H + (size_t)row * DM;
#pragma unroll
        for (int j = 0; j < 8; ++j) { const f32x4 v = ldg4(xr + 256 * j, vo), sh = ldg4(mb + 256 * j, vo), sc = ldg4(mb + 2048 + 256 * j, vo); const f32x4 h = v * (sc + 1.0f) + sh;
            v2u w; w.x = pk2(h[0], h[1]); w.y = pk2(h[2], h[3]); *(GAS v2u*)((GAS unsigned char*)(hr + 256 * j) + vh) = w; } }
    float* TAB = (float*)(a.ws + WS_TAB);
    for (int i = gw * 64 + lane; i < NTOK * 8; i += NGW * 64) { const int tok = i >> 3, f = i & 7;
        const float inv = powf(500000.0f, -(float)f * 0.125f); const float ang = (float)a.pos[tok] * inv;
        double rev = (double)ang * 0.15915494309189535; rev -= floor(rev); const float r = (float)rev;
        TAB[tok * 16 + f] = __builtin_amdgcn_cosf(r); TAB[tok * 16 + 8 + f] = __builtin_amdgcn_sinf(r); }
}

typedef short bf16x8v __attribute__((ext_vector_type(8)));
typedef short s16x4v __attribute__((ext_vector_type(4)));
__device__ __forceinline__ void unpack8(const v4u w, float (&t)[8]) { t[0] = bflo(w.x); t[1] = bfhi(w.x); t[2] = bflo(w.y); t[3] = bfhi(w.y); t[4] = bflo(w.z); t[5] = bfhi(w.z); t[6] = bflo(w.w); t[7] = bfhi(w.w); }
__device__ __forceinline__ v4u pack8(const float (&t)[8]) { v4u w; w.x = pk2(t[0], t[1]); w.y = pk2(t[2], t[3]); w.z = pk2(t[4], t[5]); w.w = pk2(t[6], t[7]); return w; }
__device__ __forceinline__ void glds16(const void* gsrc, unsigned lds_dst) { unsigned keep;
    asm volatile("s_mov_b32 %0, m0\n\ts_mov_b32 m0, %2\n\ts_nop 0\n\tglobal_load_lds_dwordx4 %1, off\n\ts_mov_b32 m0, %0" : "=&s"(keep) : "v"(gsrc), "s"(lds_dst) : "memory"); }
struct AttnU { int b, h, br, d, r, n; };
__device__ __forceinline__ AttnU attn_decode(int unit) { AttnU u; const int bh = unit / 48, x = unit - bh * 48; u.b = bh >> 4; u.h = bh & 15;
    if (x < 16) { u.br = 0; u.d = 1; u.r = 0; u.n = x; } else if (x < 32) { u.br = 1; u.d = 4; u.r = (x - 16) >> 2; u.n = (x - 16) & 3; } else { u.br = 2; u.d = 16; u.r = x - 32; u.n = 0; } return u; }
__device__ __forceinline__ void attn_issue(const Args& a, unsigned lds0, int bo, const AttnU& u, int wave, int lane) {
    const bf16* PROJ = (const bf16*)(a.ws + WS_PROJ);
#pragma unroll
    for (int j = 0; j < 4; ++j) { const int ri = wave + 8 * j, kl = 8 * ri + (lane >> 3), cp = lane & 7;
        if (u.n > 0 || ri >= 16) {
            const size_t tok = (size_t)u.b * SEQ + ((u.n - 1) * 128 + kl) * u.d + u.r; const int f = (kl >> 1) & 7;
            const bf16* kp = PROJ + tok * NIN + 1024 + u.h * 64 + 8 * (cp ^ f);
            const bf16* vp = PROJ + tok * NIN + 2048 + u.h * 64 + 8 * ((((cp >> 1) ^ (f & 3)) << 1) | (cp & 1));
            glds16(kp, (unsigned)__builtin_amdgcn_readfirstlane((int)(lds0 + bo + ri * 1024)));
            glds16(vp, (unsigned)__builtin_amdgcn_readfirstlane((int)(lds0 + bo + 32768 + ri * 1024))); } }
}
__device__ __forceinline__ void attn_compute(const Args& a, LAS unsigned char* lds, int bo, const AttnU& u, int w, int lane, bf16x8v bq0, bf16x8v bq1) {
    bf16* OB = (bf16*)(a.ws + WS_OB); float* LSE = (float*)(a.ws + WS_LSE);
    const int ql = lane & 15, g = lane >> 4, n = u.n; const int KL = bo, VL = bo + 32768;
    const int qstep = n * 128 + 16 * w + ql; const size_t qtok = (size_t)u.b * SEQ + qstep * u.d + u.r;
    f32x4 sc[9];
#pragma unroll
    for (int tt = 0; tt < 9; ++tt) { const int t = w + tt;
        if (n > 0 || t >= 8) { const int kl = 16 * t + ql, f = (kl >> 1) & 7;
            const bf16x8v ka = *(const LAS bf16x8v*)(lds + KL + kl * 128 + ((g ^ f) << 4)), kb = *(const LAS bf16x8v*)(lds + KL + kl * 128 + (((g + 4) ^ f) << 4));
            f32x4 acc = (f32x4){0.f, 0.f, 0.f, 0.f};
            acc = __builtin_amdgcn_mfma_f32_16x16x32_bf16(ka, bq0, acc, 0, 0, 0); acc = __builtin_amdgcn_mfma_f32_16x16x32_bf16(kb, bq1, acc, 0, 0, 0);
            if (tt == 0) {
#pragma unroll
                for (int e = 0; e < 4; ++e) if (4 * g + e < ql) acc[e] = -1e30f; }
            if (tt == 8) {
#pragma unroll
                for (int e = 0; e < 4; ++e) if (4 * g + e > ql) acc[e] = -1e30f; }
            sc[tt] = acc;
        } else sc[tt] = (f32x4){-1e30f, -1e30f, -1e30f, -1e30f}; }
    float mx = -1e30f;
#pragma unroll
    for (int tt = 0; tt < 9; ++tt) mx = fmaxf(fmaxf(mx, fmaxf(sc[tt][0], sc[tt][1])), fmaxf(sc[tt][2], sc[tt][3]));
    mx = fmaxf(mx, __shfl_xor(mx, 16)); mx = fmaxf(mx, __shfl_xor(mx, 32));
    float lsum = 0.f;
#pragma unroll
    for (int tt = 0; tt < 9; ++tt)
#pragma unroll
        for (int e = 0; e < 4; ++e) { const float p = __builtin_amdgcn_exp2f(sc[tt][e] - mx); sc[tt][e] = p; lsum += p; }
    lsum += __shfl_xor(lsum, 16); lsum += __shfl_xor(lsum, 32);
    f32x4 o[4];
#pragma unroll
    for (int db = 0; db < 4; ++db) o[db] = (f32x4){0.f, 0.f, 0.f, 0.f};
    const int rq = ql >> 2, rp = ql & 3;
#pragma unroll
    for (int i = 0; i < 5; ++i) { const int t0 = w + 2 * i, t1 = w + 2 * i + 1;
        if (n > 0 || t1 >= 8 || (i == 4)) {
            const bool e0 = (n > 0 || t0 >= 8), e1 = (i < 4) && (n > 0 || t1 >= 8);
            const int ta0 = e0 ? t0 : 8, ta1 = e1 ? t1 : 8;
            v4u pw; pw.x = e0 ? pk2(sc[2 * i][0], sc[2 * i][1]) : 0u; pw.y = e0 ? pk2(sc[2 * i][2], sc[2 * i][3]) : 0u;
            if (i < 4) { pw.z = e1 ? pk2(sc[2 * i + 1][0], sc[2 * i + 1][1]) : 0u; pw.w = e1 ? pk2(sc[2 * i + 1][2], sc[2 * i + 1][3]) : 0u; } else { pw.z = 0u; pw.w = 0u; }
            const bf16x8v pf = __builtin_bit_cast(bf16x8v, pw);
            const int k0 = 16 * ta0 + 4 * g + rq, k1 = 16 * ta1 + 4 * g + rq, f0 = (k0 >> 1) & 3, f1 = (k1 >> 1) & 3;
#pragma unroll
            for (int db = 0; db < 4; ++db) {
                const s16x4v va = __builtin_bit_cast(s16x4v, __builtin_amdgcn_ds_read_tr16_b64_v4i16((LAS s16x4v*)(lds + VL + k0 * 128 + ((db ^ f0) << 5) + 8 * rp)));
                const s16x4v vb = __builtin_bit_cast(s16x4v, __builtin_amdgcn_ds_read_tr16_b64_v4i16((LAS s16x4v*)(lds + VL + k1 * 128 + ((db ^ f1) << 5) + 8 * rp)));
                const bf16x8v vf = __builtin_shufflevector(va, vb, 0, 1, 2, 3, 4, 5, 6, 7);
                o[db] = __builtin_amdgcn_mfma_f32_16x16x32_bf16(vf, pf, o[db], 0, 0, 0); } } }
    const float il = 1.0f / lsum; bf16* op = OB + ((size_t)u.br * NTOK + qtok) * 1024 + u.h * 64 + 4 * g;
#pragma unroll
    for (int db = 0; db < 4; ++db) { v2u wv; wv.x = pk2(o[db][0] * il, o[db][1] * il); wv.y = pk2(o[db][2] * il, o[db][3] * il); *(GAS v2u*)(op + 16 * db) = wv; }
    if (g == 0) LSE[((size_t)u.br * NTOK + qtok) * 16 + u.h] = (mx + __builtin_amdgcn_logf(lsum)) * 0.6931471805599453f;
}
__device__ __forceinline__ void attn_phase(const Args& a, LAS unsigned char* lds, int unit0, int stride, int uend, int wave) {
    const bf16* PROJ = (const bf16*)(a.ws + WS_PROJ);
    const int lane = fresh_lane(), ql = lane & 15, g = lane >> 4; const unsigned lds0 = (unsigned)(uintptr_t)lds;
    if (unit0 >= uend) return;
    asm volatile("s_waitcnt vmcnt(0) lgkmcnt(0)" ::: "memory"); __builtin_amdgcn_s_barrier(); asm volatile("" ::: "memory");
    AttnU u = attn_decode(unit0); attn_issue(a, lds0, 0, u, wave, lane);
    bf16x8v bq0, bq1;
    { const size_t qtok = (size_t)u.b * SEQ + (u.n * 128 + 16 * wave + ql) * u.d + u.r; const bf16* qp = PROJ + qtok * NIN + u.h * 64;
      bq0 = *(const GAS bf16x8v*)(qp + 8 * g); bq1 = *(const GAS bf16x8v*)(qp + 32 + 8 * g); }
    int cur = 0;
    for (int un = unit0; un < uend; un += stride) {
        asm volatile("s_waitcnt vmcnt(0)" ::: "memory"); __builtin_amdgcn_s_barrier(); asm volatile("" ::: "memory");
        const bool more = un + stride < uend; AttnU v = u; bf16x8v nq0 = bq0, nq1 = bq1;
        if (more) { v = attn_decode(un + stride); attn_issue(a, lds0, (cur ^ 1) * 65536, v, wave, lane);
            const size_t qtok = (size_t)v.b * SEQ + (v.n * 128 + 16 * wave + ql) * v.d + v.r; const bf16* qp = PROJ + qtok * NIN + v.h * 64;
            nq0 = *(const GAS bf16x8v*)(qp + 8 * g); nq1 = *(const GAS bf16x8v*)(qp + 32 + 8 * g); }
        attn_compute(a, lds, cur * 65536, u, wave, lane, bq0, bq1);
        u = v; bq0 = nq0; bq1 = nq1; cur ^= 1; }
    asm volatile("s_waitcnt vmcnt(0) lgkmcnt(0)" ::: "memory"); __builtin_amdgcn_s_barrier(); asm volatile("" ::: "memory");
}
__device__ __forceinline__ s16x4v trrd(const LAS unsigned char* p) { return __builtin_bit_cast(s16x4v, __builtin_amdgcn_ds_read_tr16_b64_v4i16((LAS s16x4v*)p)); }
__device__ __forceinline__ bf16x8v cat8(s16x4v a, s16x4v b) { return __builtin_shufflevector(a, b, 0, 1, 2, 3, 4, 5, 6, 7); }
__device__ __forceinline__ int hg_fsw(int k) { return ((k >> 1) & 1) | (((k >> 3) & 1) << 1); }
__device__ __forceinline__ int hg_row32(int r) { return (r * 32) ^ (((r >> 3) & 1) << 7); }
__device__ __forceinline__ void hgrn_prep(const Args& a, LAS unsigned char* lds, int unit, int wave) {
    const bf16* PROJ = (const bf16*)(a.ws + WS_PROJ); unsigned char* IMG = a.ws + WS_HIMG + (size_t)unit * 32768; float* SCAL = (float*)(a.ws + WS_HSC) + (size_t)unit * 256;
    const int lane = fresh_lane(), tid = wave * 64 + lane, pk = tid & 127, tg = tid >> 7;
    const int b = unit >> 8, h = (unit >> 5) & 7, ch = unit & 31;
    const float lbk = 1.0f / (1.0f + __expf(a.hgrn_lb[1024 + h * 128 + pk] - a.hgrn_lb[h * 128 + pk]));
    float fq[16], fc[16], ff[16];
    const bf16* src = PROJ + ((size_t)b * SEQ + ch * 64 + 16 * tg) * NIN + h * 128 + pk;
#pragma unroll
    for (int j = 0; j < 16; ++j) { fq[j] = __builtin_bit_cast(float, (unsigned)src[(size_t)j * NIN + 3072] << 16); ff[j] = __builtin_bit_cast(float, (unsigned)src[(size_t)j * NIN + 4096] << 16); }
#pragma unroll
    for (int j = 0; j < 16; ++j) { ff[j] = lbk + (1.0f - lbk) / (1.0f + __expf(-ff[j])); fc[j] = (j == 0) ? ff[0] : fc[j - 1] * ff[j]; }
    LAS float* TOT = (LAS float*)lds;
    __syncthreads();
    TOT[tg * 128 + pk] = fc[15];
    __syncthreads();
    const float t0 = TOT[pk], t1 = TOT[128 + pk], t2 = TOT[256 + pk], t3 = TOT[384 + pk];
    const float pref = t0 * t1, pall = pref * t2 * t3, pre = (tg == 0) ? 1.0f : (tg == 1) ? t0 : (tg == 2) ? pref : pref * t2, rpref = 1.0f / pref;
    float oq[16], ok[16];
#pragma unroll
    for (int j = 0; j < 16; ++j) { const float P = pre * fc[j]; oq[j] = fq[j] * P * rpref; ok[j] = (1.0f - ff[j]) * pref / P; }
    const int wo = pk * 128 + ((tg ^ hg_fsw(pk)) << 5);
    v4u w0, w1;
    w0.x = pg8::cvt_pk_bf16(oq[0], oq[1]); w0.y = pg8::cvt_pk_bf16(oq[2], oq[3]); w0.z = pg8::cvt_pk_bf16(oq[4], oq[5]); w0.w = pg8::cvt_pk_bf16(oq[6], oq[7]);
    w1.x = pg8::cvt_pk_bf16(oq[8], oq[9]); w1.y = pg8::cvt_pk_bf16(oq[10], oq[11]); w1.z = pg8::cvt_pk_bf16(oq[12], oq[13]); w1.w = pg8::cvt_pk_bf16(oq[14], oq[15]);
    *(GAS v4u*)(IMG + wo) = w0; *(GAS v4u*)(IMG + wo + 16) = w1;
    w0.x = pg8::cvt_pk_bf16(ok[0], ok[1]); w0.y = pg8::cvt_pk_bf16(ok[2], ok[3]); w0.z = pg8::cvt_pk_bf16(ok[4], ok[5]); w0.w = pg8::cvt_pk_bf16(ok[6], ok[7]);
    w1.x = pg8::cvt_pk_bf16(ok[8], ok[9]); w1.y = pg8::cvt_pk_bf16(ok[10], ok[11]); w1.z = pg8::cvt_pk_bf16(ok[12], ok[13]); w1.w = pg8::cvt_pk_bf16(ok[14], ok[15]);
    *(GAS v4u*)(IMG + 16384 + wo) = w0; *(GAS v4u*)(IMG + 16384 + wo + 16) = w1;
    if (tg == 0) { SCAL[pk] = pref; SCAL[128 + pk] = pall; }
}
__device__ __forceinline__ void hgrn_unit(const Args& a, LAS unsigned char* lds, int unit, int wave) {
    const bf16* PROJ = (const bf16*)(a.ws + WS_PROJ); float* ORAW = (float*)(a.ws + WS_ORAW);
    const int lane = fresh_lane(), tid = wave * 64 + lane;
    const int vs = unit & 7, h = (unit >> 3) & 7, b = unit >> 6;
    const unsigned char* IMG = a.ws + WS_HIMG + (size_t)((b * 8 + h) * 32) * 32768; const float* SCAL = (const float*)(a.ws + WS_HSC) + (size_t)((b * 8 + h) * 32) * 256;
    constexpr int BUF = 36864, OQT = 0, OKT = 16384, OV = 32768, OSC = 34816, ST = 73728;
    const int i16 = lane & 15, g = lane >> 4, rq = i16 >> 2, rp = i16 & 3; const unsigned lds0 = (unsigned)(uintptr_t)lds;
#define HG_BAR() do { asm volatile("" ::: "memory"); __builtin_amdgcn_s_barrier(); asm volatile("" ::: "memory"); } while (0)
#define HG_ISSUE(ch, bo) do { const unsigned char* gsrc = IMG + (size_t)(ch) * 32768 + tid * 16; \
        _Pragma("unroll") for (int r = 0; r < 4; ++r) glds16(gsrc + r * 8192, (unsigned)__builtin_amdgcn_readfirstlane((int)(lds0 + (bo) + wave * 1024 + r * 8192))); \
        { const int idx = tid * 2, t = idx >> 4, v = idx & 15; pi = *(const GAS unsigned*)(PROJ + ((size_t)b * SEQ + (ch) * 64 + t) * NIN + 5120 + h * 128 + vs * 16 + v); } \
        psc = (tid < 256) ? SCAL[(size_t)(ch) * 256 + tid] : 0.f; } while (0)
#define HG_LAND(bo) do { { const int idx = tid * 2, t = idx >> 4, v = idx & 15; *(LAS unsigned*)(lds + (bo) + OV + hg_row32(t) + v * 2) = pi; } \
        if (tid < 256) ((LAS float*)(lds + (bo) + OSC))[tid] = psc; asm volatile("s_waitcnt vmcnt(0) lgkmcnt(0)" ::: "memory"); } while (0)
    unsigned pi; float psc;
    asm volatile("s_waitcnt vmcnt(0) lgkmcnt(0)" ::: "memory"); HG_BAR();
    HG_ISSUE(0, 0); HG_LAND(0);
    f32x4 S[2]; S[0] = (f32x4){0.f, 0.f, 0.f, 0.f}; S[1] = S[0];
    for (int ch = 0; ch < 32; ++ch) {
        const int bc = (ch & 1) * BUF, bn = BUF - bc;
        HG_BAR();
        if (wave >= 4) {
#pragma unroll
            for (int q2 = 0; q2 < 2; ++q2) { const int k = 16 * (2 * (wave - 4) + q2) + i16; const float pr = ((const LAS float*)(lds + bc + OSC))[k];
                v2u w; w.x = pg8::cvt_pk_bf16(S[q2][0] * pr, S[q2][1] * pr); w.y = pg8::cvt_pk_bf16(S[q2][2] * pr, S[q2][3] * pr); *(LAS v2u*)(lds + ST + hg_row32(k) + 8 * g) = w; } }
        if (ch + 1 < 32) HG_ISSUE(ch + 1, bn);
        asm volatile("s_waitcnt lgkmcnt(0)" ::: "memory"); HG_BAR();
        if (wave < 4) {
            const int w = wave; f32x4 acc = (f32x4){0.f, 0.f, 0.f, 0.f}; bf16x8v Bq[4];
#pragma unroll
            for (int ks = 0; ks < 4; ++ks) { const int k0 = 32 * ks + 8 * g + rq, k1 = k0 + 4;
                Bq[ks] = cat8(trrd(lds + bc + OQT + k0 * 128 + ((w ^ hg_fsw(k0)) << 5) + 8 * rp), trrd(lds + bc + OQT + k1 * 128 + ((w ^ hg_fsw(k1)) << 5) + 8 * rp));
                const bf16x8v A = cat8(trrd(lds + ST + hg_row32(k0) + 8 * rp), trrd(lds + ST + hg_row32(k1) + 8 * rp));
                acc = __builtin_amdgcn_mfma_f32_16x16x32_bf16(A, Bq[ks], acc, 0, 0, 0); }
            f32x4 p[4];
#pragma unroll
            for (int st = 0; st < 4; ++st) { p[st] = (f32x4){0.f, 0.f, 0.f, 0.f};
                if (st <= w) { f32x4 d = (f32x4){0.f, 0.f, 0.f, 0.f};
#pragma unroll
                    for (int ks = 0; ks < 4; ++ks) { const int k0 = 32 * ks + 8 * g + rq, k1 = k0 + 4;
                        const bf16x8v A = cat8(trrd(lds + bc + OKT + k0 * 128 + ((st ^ hg_fsw(k0)) << 5) + 8 * rp), trrd(lds + bc + OKT + k1 * 128 + ((st ^ hg_fsw(k1)) << 5) + 8 * rp));
                        d = __builtin_amdgcn_mfma_f32_16x16x32_bf16(A, Bq[ks], d, 0, 0, 0); }
                    if (st == w) {
#pragma unroll
                        for (int e = 0; e < 4; ++e) if (4 * g + e > i16) d[e] = 0.f; }
                    p[st] = d; } }
#pragma unroll
            for (int pr = 0; pr < 2; ++pr) { const int s0 = 2 * pr, s1 = 2 * pr + 1;
                if (s0 <= w) { const int s1a = (s1 <= w) ? s1 : s0;
                    v4u pw; pw.x = pg8::cvt_pk_bf16(p[s0][0], p[s0][1]); pw.y = pg8::cvt_pk_bf16(p[s0][2], p[s0][3]); pw.z = (s1 <= w) ? pg8::cvt_pk_bf16(p[s1][0], p[s1][1]) : 0u; pw.w = (s1 <= w) ? pg8::cvt_pk_bf16(p[s1][2], p[s1][3]) : 0u;
                    const bf16x8v V = cat8(trrd(lds + bc + OV + hg_row32(16 * s0 + 4 * g + rq) + 8 * rp), trrd(lds + bc + OV + hg_row32(16 * s1a + 4 * g + rq) + 8 * rp));
                    acc = __builtin_amdgcn_mfma_f32_16x16x32_bf16(V, __builtin_bit_cast(bf16x8v, pw), acc, 0, 0, 0); } }
            *(GAS f32x4*)(ORAW + ((size_t)b * SEQ + ch * 64 + 16 * w + i16) * 1024 + h * 128 + vs * 16 + 4 * g) = acc;
        } else {
#pragma unroll
            for (int q2 = 0; q2 < 2; ++q2) { const int k = 16 * (2 * (wave - 4) + q2) + i16;
                const float pr = ((const LAS float*)(lds + bc + OSC))[k], pa = ((const LAS float*)(lds + bc + OSC))[128 + k];
                f32x4 d = (f32x4){0.f, 0.f, 0.f, 0.f};
#pragma unroll
                for (int ss = 0; ss < 2; ++ss) { const int s0 = 32 * ss + 8 * g + rq;
                    const bf16x8v A = cat8(trrd(lds + bc + OV + hg_row32(s0) + 8 * rp), trrd(lds + bc + OV + hg_row32(s0 + 4) + 8 * rp));
                    const bf16x8v B = *(const LAS bf16x8v*)(lds + bc + OKT + k * 128 + (((2 * ss + (g >> 1)) ^ hg_fsw(k)) << 5) + (g & 1) * 16);
                    d = __builtin_amdgcn_mfma_f32_16x16x32_bf16(A, B, d, 0, 0, 0); }
                S[q2] = S[q2] * pa + d * (pa * __builtin_amdgcn_rcpf(pr)); }
        }
        if (ch + 1 < 32) HG_LAND(bn); else asm volatile("s_waitcnt vmcnt(0) lgkmcnt(0)" ::: "memory");
    }
#undef HG_ISSUE
#undef HG_LAND
    HG_BAR();
#undef HG_BAR
}
__device__ __forceinline__ void p3b_rec(const Args& a, int gw, int NGW, int lane) {
    const bf16* PROJ = (const bf16*)(a.ws + WS_PROJ); const float* ORAW = (const float*)(a.ws + WS_ORAW); bf16* MIXED = (bf16*)(a.ws + WS_MIXED);
    for (int tok = gw; tok < NTOK; tok += NGW) {
        const float* op = ORAW + (size_t)tok * 1024 + 16 * lane; float o[16]; float ss = 0.f;
#pragma unroll
        for (int j = 0; j < 4; ++j) { const f32x4 v = *(const GAS f32x4*)(op + 4 * j); o[4 * j] = v[0]; o[4 * j + 1] = v[1]; o[4 * j + 2] = v[2]; o[4 * j + 3] = v[3]; ss += (v[0] * v[0] + v[1] * v[1]) + (v[2] * v[2] + v[3] * v[3]); }
        ss += __shfl_xor(ss, 1); ss += __shfl_xor(ss, 2); ss += __shfl_xor(ss, 4);
        const float r = 1.0f / sqrtf(ss * (1.0f / 128.0f) + 1e-6f);
        const bf16* gp = PROJ + (size_t)tok * NIN + 6144 + 16 * lane; const float* gn = a.gnorm_w + 16 * lane; float g[16];
        { const v4u w0 = *(const GAS v4u*)gp, w1 = *(const GAS v4u*)(gp + 8); const unsigned ww[8] = {w0.x, w0.y, w0.z, w0.w, w1.x, w1.y, w1.z, w1.w};
#pragma unroll
            for (int e = 0; e < 8; ++e) { g[2 * e] = bflo(ww[e]); g[2 * e + 1] = bfhi(ww[e]); } }
        float y[16];
#pragma unroll
        for (int e = 0; e < 16; ++e) y[e] = o[e] * r * gn[e] * (g[e] / (1.0f + __expf(-g[e])));
        bf16* mp = MIXED + (size_t)tok * DM + 1024 + 16 * lane;
        v4u w; w.x = pk2(y[0], y[1]); w.y = pk2(y[2], y[3]); w.z = pk2(y[4], y[5]); w.w = pk2(y[6], y[7]); *(GAS v4u*)mp = w;
        w.x = pk2(y[8], y[9]); w.y = pk2(y[10], y[11]); w.z = pk2(y[12], y[13]); w.w = pk2(y[14], y[15]); *(GAS v4u*)(mp + 8) = w;
        { const bf16* OB = (const bf16*)(a.ws + WS_OB); const float* LSE = (const float*)(a.ws + WS_LSE); const int hd = lane >> 2;
            const float l0 = LSE[((size_t)0 * NTOK + tok) * 16 + hd], l1 = LSE[((size_t)1 * NTOK + tok) * 16 + hd], l2 = LSE[((size_t)2 * NTOK + tok) * 16 + hd];
            const float lm = fmaxf(l0, fmaxf(l1, l2)); float wt[3] = {__expf(l0 - lm), __expf(l1 - lm), __expf(l2 - lm)}; const float inv = 1.0f / (wt[0] + wt[1] + wt[2]);
            float acc[16];
#pragma unroll
            for (int e = 0; e < 16; ++e) acc[e] = 0.f;
#pragma unroll
            for (int i = 0; i < 3; ++i) { const bf16* p = OB + ((size_t)i * NTOK + tok) * 1024 + 16 * lane; const v4u w0 = *(const GAS v4u*)p, w1 = *(const GAS v4u*)(p + 8); float t0[8], t1[8]; unpack8(w0, t0); unpack8(w1, t1); const float ww = wt[i] * inv;
#pragma unroll
                for (int e = 0; e < 8; ++e) { acc[e] += ww * t0[e]; acc[8 + e] += ww * t1[e]; } }
            bf16* ap = MIXED + (size_t)tok * DM + 16 * lane; float lo[8], hi[8];
#pragma unroll
            for (int e = 0; e < 8; ++e) { lo[e] = acc[e]; hi[e] = acc[8 + e]; }
            *(GAS v4u*)ap = pack8(lo); *(GAS v4u*)(ap + 8) = pack8(hi); }
    }
}
__device__ __forceinline__ void p5a_row2(const Args& a, const int row0, int lane) {
    const float* MOD = (const float*)(a.ws + WS_MOD); const bf16* MIXB = (const bf16*)(a.ws + WS_MIXF); float* X1 = (float*)(a.ws + WS_X1); unsigned char* H2 = a.ws + WS_H;
    const unsigned vo = (unsigned)lane * 16u;
    const int b = row0 >> 11; const float* mb = MOD + b * 12288; const float* xr = a.x + (size_t)row0 * DM; const bf16* mr = MIXB + (size_t)row0 * DM;
    float* x1r = X1 + (size_t)row0 * DM; unsigned char* h2r = H2 + (size_t)row0 * DM;
    f32x4 v0[8], v1[8]; float s0 = 0.f, s1 = 0.f;
#pragma unroll
    for (int j = 0; j < 8; ++j) { const f32x4 gt = ldg4(mb + 4096 + 256 * j, vo) + 1.0f, xa = ldg4(xr + 256 * j, vo), xb = ldg4(xr + DM + 256 * j, vo); const v2u ma = ldg2(mr + 256 * j, vo >> 1), mc = ldg2(mr + DM + 256 * j, vo >> 1);
        v0[j] = xa * ALPHA_DN + gt * (f32x4){bflo(ma.x), bfhi(ma.x), bflo(ma.y), bfhi(ma.y)}; v1[j] = xb * ALPHA_DN + gt * (f32x4){bflo(mc.x), bfhi(mc.x), bflo(mc.y), bfhi(mc.y)};
        s0 += (v0[j][0] + v0[j][1]) + (v0[j][2] + v0[j][3]); s1 += (v1[j][0] + v1[j][1]) + (v1[j][2] + v1[j][3]); }
    const float mean0 = wave_sum(s0) * (1.0f / DM), mean1 = wave_sum(s1) * (1.0f / DM); float q0 = 0.f, q1 = 0.f;
#pragma unroll
    for (int j = 0; j < 8; ++j) { v0[j] = v0[j] - mean0; v1[j] = v1[j] - mean1; q0 += (v0[j][0] * v0[j][0] + v0[j][1] * v0[j][1]) + (v0[j][2] * v0[j][2] + v0[j][3] * v0[j][3]);
        q1 += (v1[j][0] * v1[j][0] + v1[j][1] * v1[j][1]) + (v1[j][2] * v1[j][2] + v1[j][3] * v1[j][3]); }
    const float rstd0 = 1.0f / sqrtf(wave_sum(q0) * (1.0f / DM) + 1e-5f), rstd1 = 1.0f / sqrtf(wave_sum(q1) * (1.0f / DM) + 1e-5f);
#pragma unroll
    for (int j = 0; j < 8; ++j) { const f32x4 g = ldg4(a.ln1_g + 256 * j, vo), bb = ldg4(a.ln1_b + 256 * j, vo), sh = ldg4(mb + 3 * 2048 + 256 * j, vo), sc = ldg4(mb + 4 * 2048 + 256 * j, vo) + 1.0f;
        const f32x4 xa = v0[j] * rstd0 * g + bb, xb = v1[j] * rstd1 * g + bb; stg4(x1r + 256 * j, vo, xa); stg4(x1r + DM + 256 * j, vo, xb);
        const f32x4 ha = xa * sc + sh, hb = xb * sc + sh; unsigned w = 0u, w2 = 0u;
        w = __builtin_amdgcn_cvt_pk_fp8_f32(ha[0], ha[1], w, false); w = __builtin_amdgcn_cvt_pk_fp8_f32(ha[2], ha[3], w, true); *(GAS unsigned*)((GAS unsigned char*)(h2r + 256 * j) + (vo >> 2)) = w;
        w2 = __builtin_amdgcn_cvt_pk_fp8_f32(hb[0], hb[1], w2, false); w2 = __builtin_amdgcn_cvt_pk_fp8_f32(hb[2], hb[3], w2, true); *(GAS unsigned*)((GAS unsigned char*)(h2r + DM + 256 * j) + (vo >> 2)) = w2; }
}
__device__ __forceinline__ void p5_ln_router(const Args& a, LAS unsigned char* lds, int blk, int nblk, int wave) {
    const float* X1 = (const float*)(a.ws + WS_X1); const float* MOD = (const float*)(a.ws + WS_MOD); const bf16* RH = (const bf16*)(a.ws + WS_RWT); const bf16* RL = RH + NEXP * DM;
    gu32* cnt = (gu32*)(a.ws + WS_CTL) + CW_CNT; int* AE = (int*)(a.ws + WS_ASG); int* AP = AE + 32768; float* AG = (float*)(AP + 32768);
    const int lane = fresh_lane(), i16 = lane & 15, g = lane >> 4;
    LAS float* part = (LAS float*)lds;
    for (int t0 = blk; t0 < NTOK / 16; t0 += 3 * nblk) {
        const int nt = (t0 + 2 * nblk < NTOK / 16) ? 3 : (t0 + nblk < NTOK / 16) ? 2 : 1;
#pragma unroll 1
        for (int t = 0; t < nt; ++t) p5a_row2(a, (t0 + t * nblk) * 16 + 2 * wave, lane);
        asm volatile("s_waitcnt vmcnt(0)" ::: "memory"); __syncthreads();
        f32x4 acc[3][2];
#pragma unroll
        for (int t = 0; t < 3; ++t) { acc[t][0] = (f32x4){0.f, 0.f, 0.f, 0.f}; acc[t][1] = acc[t][0]; }
        const unsigned lx = (unsigned)(i16 * DM + 8 * g) * 4u, lm = (unsigned)(8 * g) * 4u, lr = (unsigned)(i16 * DM + 8 * g) * 2u;
#pragma unroll 2
        for (int ks = 0; ks < 8; ++ks) { const int kw = wave * 256 + ks * 32;
            const bf16x8v b0h = __builtin_bit_cast(bf16x8v, ldg4(RH + kw, lr)), b0l = __builtin_bit_cast(bf16x8v, ldg4(RL + kw, lr));
            const bf16x8v b1h = __builtin_bit_cast(bf16x8v, ldg4(RH + 16 * DM + kw, lr)), b1l = __builtin_bit_cast(bf16x8v, ldg4(RL + 16 * DM + kw, lr));
#pragma unroll
            for (int t = 0; t < 3; ++t) if (t < nt) { const int tile = t0 + t * nblk;
                const float* xp = X1 + (size_t)(tile * 16) * DM + kw; const float* mb = MOD + ((tile * 16) >> 11) * 12288 + kw;
                bf16x8v fah, fal;
                { const f32x4 xa = ldg4(xp, lx), xb = ldg4(xp + 4, lx), sa = ldg4(mb + 4 * 2048, lm), sb = ldg4(mb + 4 * 2048 + 4, lm), ha = ldg4(mb + 3 * 2048, lm), hb = ldg4(mb + 3 * 2048 + 4, lm);
                  const f32x4 h0 = xa * (sa + 1.0f) + ha, h1 = xb * (sb + 1.0f) + hb; unsigned hi[4], lo[4];
#pragma unroll
                  for (int q = 0; q < 2; ++q) { const unsigned a0 = f2bf(h0[2 * q]), a1 = f2bf(h0[2 * q + 1]), c0 = f2bf(h1[2 * q]), c1 = f2bf(h1[2 * q + 1]);
                      hi[q] = a0 | (a1 << 16); hi[2 + q] = c0 | (c1 << 16);
                      lo[q] = pk2(h0[2 * q] - __builtin_bit_cast(float, a0 << 16), h0[2 * q + 1] - __builtin_bit_cast(float, a1 << 16)); lo[2 + q] = pk2(h1[2 * q] - __builtin_bit_cast(float, c0 << 16), h1[2 * q + 1] - __builtin_bit_cast(float, c1 << 16)); }
                  v4u vh, vl; vh.x = hi[0]; vh.y = hi[1]; vh.z = hi[2]; vh.w = hi[3]; vl.x = lo[0]; vl.y = lo[1]; vl.z = lo[2]; vl.w = lo[3];
                  fah = __builtin_bit_cast(bf16x8v, vh); fal = __builtin_bit_cast(bf16x8v, vl); }
                acc[t][0] = __builtin_amdgcn_mfma_f32_16x16x32_bf16(fah, b0h, acc[t][0], 0, 0, 0); acc[t][0] = __builtin_amdgcn_mfma_f32_16x16x32_bf16(fah, b0l, acc[t][0], 0, 0, 0); acc[t][0] = __builtin_amdgcn_mfma_f32_16x16x32_bf16(fal, b0h, acc[t][0], 0, 0, 0);
                acc[t][1] = __builtin_amdgcn_mfma_f32_16x16x32_bf16(fah, b1h, acc[t][1], 0, 0, 0); acc[t][1] = __builtin_amdgcn_mfma_f32_16x16x32_bf16(fah, b1l, acc[t][1], 0, 0, 0); acc[t][1] = __builtin_amdgcn_mfma_f32_16x16x32_bf16(fal, b1h, acc[t][1], 0, 0, 0); } }
        __syncthreads();
#pragma unroll
        for (int t = 0; t < 3; ++t) if (t < nt) {
#pragma unroll
            for (int e = 0; e < 4; ++e) { part[((t * 8 + wave) * 16 + 4 * g + e) * 33 + i16] = acc[t][0][e]; part[((t * 8 + wave) * 16 + 4 * g + e) * 33 + 16 + i16] = acc[t][1][e]; } }
        __syncthreads();
        if (wave < nt && lane < 16) { const int row = (t0 + wave * nblk) * 16 + lane; float lg[32];
#pragma unroll
            for (int e = 0; e < 32; ++e) { float sacc = a.router_b[e];
#pragma unroll
                for (int w = 0; w < 8; ++w) sacc += part[((wave * 8 + w) * 16 + lane) * 33 + e];
                lg[e] = sacc; }
            float bv[4]; int bi[4];
#pragma unroll
            for (int q = 0; q < 4; ++q) { float best = -3.0e38f; int idx = 0;
#pragma unroll
                for (int e = 0; e < 32; ++e) { const bool taken = (q > 0 && e == bi[0]) || (q > 1 && e == bi[1]) || (q > 2 && e == bi[2]); if (!taken && lg[e] > best) { best = lg[e]; idx = e; } }
                bv[q] = best; bi[q] = idx; }
            const float e1 = __expf(bv[1] - bv[0]), e2 = __expf(bv[2] - bv[0]), e3 = __expf(bv[3] - bv[0]), inv = 1.0f / (1.0f + e1 + e2 + e3);
            const float gts[4] = {inv, e1 * inv, e2 * inv, e3 * inv};
#pragma unroll
            for (int q = 0; q < 4; ++q) { const unsigned p = __hip_atomic_fetch_add(cnt + 16 * bi[q], 1u, RLX_AGENT); AE[row * 4 + q] = bi[q]; AP[row * 4 + q] = (int)p; AG[row * 4 + q] = gts[q]; } }
    }
    __syncthreads();
}
__device__ __forceinline__ void moe_tables(const Args& a, LAS unsigned char* lds, int tid) {
    LAS int* tb = (LAS int*)(lds + TAB_OFF);
    if (tid == 0) { const gu32* cnt = (const gu32*)(a.ws + WS_CTL) + CW_CNT; int t = 0;
        for (int e = 0; e < NEXP; ++e) { const int n = (int)__hip_atomic_load(cnt + 16 * e, RLX_AGENT); const int nt = (n + 255) >> 8; tb[e] = t; for (int i = 0; i < nt && t + i < 160; ++i) tb[64 + t + i] = e; t += nt; if (t > 160) t = 160; }
        tb[32] = t; }
    __syncthreads();
}
__device__ __forceinline__ void p6_gather(const Args& a, LAS unsigned char* lds, int gw, int NGW, int lane) {
    const LAS int* tb = (const LAS int*)(lds + TAB_OFF);
    const int* AE = (const int*)(a.ws + WS_ASG); const int* AP = AE + 32768; const float* AG = (const float*)(AP + 32768); int* AR = (int*)(AG + 32768);
    float* RG = (float*)(a.ws + WS_RGATE); int* RT = (int*)(a.ws + WS_ROWTOK);
    for (int as = gw; as < 32768; as += NGW) { const int e = AE[as], row = tb[e] * 256 + AP[as];
        if (lane == 0) { AR[as] = row; RG[row] = AG[as]; RT[row] = as >> 2; }
        }
}
__device__ __forceinline__ void p9_final(const Args& a, int gw, int NGW, int lane) {
    const float* MOD = (const float*)(a.ws + WS_MOD); const float* X1 = (const float*)(a.ws + WS_X1); const unsigned char* Y = a.ws + WS_Y;
    const int* AR = (const int*)(a.ws + WS_ASG) + 3 * 32768; const unsigned vo = (unsigned)lane * 16u, vq = (unsigned)lane * 4u;
    for (int row = gw; row < NTOK; row += NGW) { const int b = row >> 11; const float* mb = MOD + b * 12288 + 5 * 2048; const float* xr = X1 + (size_t)row * DM; float* orow = a.out + (size_t)row * DM;
        const unsigned char* y0 = Y + (size_t)__builtin_amdgcn_readfirstlane(AR[row * 4]) * DM; const unsigned char* y1 = Y + (size_t)__builtin_amdgcn_readfirstlane(AR[row * 4 + 1]) * DM;
        const unsigned char* y2 = Y + (size_t)__builtin_amdgcn_readfirstlane(AR[row * 4 + 2]) * DM; const unsigned char* y3 = Y + (size_t)__builtin_amdgcn_readfirstlane(AR[row * 4 + 3]) * DM;
        f32x4 v[8]; float s = 0.f;
#pragma unroll
        for (int j = 0; j < 8; ++j) { const f32x4 xv = ldg4(xr + 256 * j, vo), gt = ldg4(mb + 256 * j, vo);
            const unsigned w0 = *(const GAS unsigned*)((const GAS unsigned char*)(y0 + 256 * j) + vq), w1 = *(const GAS unsigned*)((const GAS unsigned char*)(y1 + 256 * j) + vq), w2 = *(const GAS unsigned*)((const GAS unsigned char*)(y2 + 256 * j) + vq), w3 = *(const GAS unsigned*)((const GAS unsigned char*)(y3 + 256 * j) + vq);
            f32x4 ff;
            ff[0] = ((__builtin_amdgcn_cvt_f32_fp8(w0, 0) + __builtin_amdgcn_cvt_f32_fp8(w1, 0)) + __builtin_amdgcn_cvt_f32_fp8(w2, 0)) + __builtin_amdgcn_cvt_f32_fp8(w3, 0);
            ff[1] = ((__builtin_amdgcn_cvt_f32_fp8(w0, 1) + __builtin_amdgcn_cvt_f32_fp8(w1, 1)) + __builtin_amdgcn_cvt_f32_fp8(w2, 1)) + __builtin_amdgcn_cvt_f32_fp8(w3, 1);
            ff[2] = ((__builtin_amdgcn_cvt_f32_fp8(w0, 2) + __builtin_amdgcn_cvt_f32_fp8(w1, 2)) + __builtin_amdgcn_cvt_f32_fp8(w2, 2)) + __builtin_amdgcn_cvt_f32_fp8(w3, 2);
            ff[3] = ((__builtin_amdgcn_cvt_f32_fp8(w0, 3) + __builtin_amdgcn_cvt_f32_fp8(w1, 3)) + __builtin_amdgcn_cvt_f32_fp8(w2, 3)) + __builtin_amdgcn_cvt_f32_fp8(w3, 3);
            v[j] = xv * ALPHA_DN + (gt + 1.0f) * ff; s += (v[j][0] + v[j][1]) + (v[j][2] + v[j][3]); }
        const float mean = wave_sum(s) * (1.0f / DM); float s2 = 0.f;
#pragma unroll
        for (int j = 0; j < 8; ++j) { v[j] = v[j] - mean; s2 += (v[j][0] * v[j][0] + v[j][1] * v[j][1]) + (v[j][2] * v[j][2] + v[j][3] * v[j][3]); }
        const float rstd = 1.0f / sqrtf(wave_sum(s2) * (1.0f / DM) + 1e-5f);
#pragma unroll
        for (int j = 0; j < 8; ++j) { const f32x4 g = ldg4(a.ln2_g + 256 * j, vo), bb = ldg4(a.ln2_b + 256 * j, vo); stg4(orow + 256 * j, vo, v[j] * rstd * g + bb); } }
}

__global__ void __launch_bounds__(NWAVES * 64, 2) fwd(Args a) {
    extern __shared__ __attribute__((aligned(16))) unsigned char lds_raw[];
    LAS unsigned char* lds = (LAS unsigned char*)lds_raw;
    const int wave = wave_id();
#define TID (wave * 64 + fresh_lane())
#define LANE fresh_lane()
    const int G = gridDim.x, gw = blockIdx.x * NWAVES + wave, NGW = G * NWAVES;
    for (int u = TID; u < (LDS_BYTES - LDSCTL_OFF) / 4; u += NWAVES * 64) ((LAS unsigned*)(lds + LDSCTL_OFF))[u] = 0u;
    __syncthreads();
    constexpr int CK = 2;
    const int bx = blockIdx.x; const bool split = (G == 256); const int oct = (bx >> 3) & 7; const bool conv = split && (oct >= 8 - CK);
    const int Gc = split ? (256 - 32 * CK) : G, Gv = 32 * CK;
    const int cidx = !split ? bx : conv ? ((bx >> 6) * (CK * 8) + (oct - (8 - CK)) * 8 + (bx & 7)) : ((bx >> 6) * ((8 - CK) * 8) + oct * 8 + (bx & 7));
    const int gwc = cidx * NWAVES + wave, NGWc = Gc * NWAVES;
    XcdBarrier bar = xcd_barrier_post((unsigned*)(a.ws + WS_CTL) + CW_BAR, (volatile LAS unsigned*)(lds + MISC_OFF) + 8, wave, (unsigned)G);
    XcdBarrier bsub = bar;
    if (split && !conv) bsub = xcd_barrier_post((unsigned*)(a.ws + WS_CTL) + CW_BAR2, (volatile LAS unsigned*)(lds + MISC_OFF) + 12, wave, (unsigned)Gc);

    if (conv) {
        conv8_weights_dyn(a, LANE, TR8_ITEMS);
    } else {
    p0_mod(a, lds, TID, cidx, Gc);
    p0_weights(a, gwc, NGWc, LANE, 0, TR_ITEMS_DENSE);
    if (!split) conv8_weights(a, gw, NGW, LANE, 0, TR8_ITEMS);
    p0_small(a, gwc, NGWc, LANE);
    xcd_barrier(bsub);
    p1_h(a, gwc, NGWc, LANE);
    xcd_barrier(bsub);
    { pg8::Gemm g{(const pg8::bf16_t*)(a.ws + WS_H), (const pg8::bf16_t*)(a.ws + WS_WINT), NTOK, NIN, DM, nullptr}; pg8::StaticOrder S; S.init(NTOK, NIN, Gc, cidx);
      pg8::EpiProj E{(pg8::bf16_t*)(a.ws + WS_PROJ), NIN, (const float*)(a.ws + WS_TAB)};
      pg8::gemm_phase<pg8::EpiProj, pg8::StaticOrder, true, true>(lds, g, S, E, wave); }
    xcd_barrier(bsub);
    for (int u = cidx; u < 1024; u += Gc) hgrn_prep(a, lds, u, wave);
    xcd_barrier(bsub);
    for (int u = cidx; u < 256; u += Gc) hgrn_unit(a, lds, u, wave);
    if (split && Gc == 192) { if (cidx < 64) attn_phase(a, lds, cidx, 64, 512, wave); else attn_phase(a, lds, 512 + (cidx - 64), 128, 3072, wave); }
    else attn_phase(a, lds, cidx, Gc, 3072, wave);
    xcd_barrier(bsub);
    p3b_rec(a, gwc, NGWc, LANE);
    xcd_barrier(bsub);
    { pg8::Gemm g{(const pg8::bf16_t*)(a.ws + WS_MIXED), (const pg8::bf16_t*)(a.ws + WS_WOT), NTOK, DM, DM, nullptr}; pg8::StaticOrder S; S.init(NTOK, DM, Gc, cidx);
      pg8::EpiStoreBf16 E{(pg8::bf16_t*)(a.ws + WS_MIXF), DM};
      pg8::gemm_phase<pg8::EpiStoreBf16, pg8::StaticOrder, true, true>(lds, g, S, E, wave); }
    xcd_barrier(bsub);
    p5_ln_router(a, lds, cidx, Gc, wave);
    if (split) conv8_weights_dyn(a, LANE, TR8_ITEMS);
    }
    xcd_barrier(bar);
    moe_tables(a, lds, TID);
    p6_gather(a, lds, gw, NGW, LANE);
    if (split) conv8_weights(a, gw, NGW, LANE, TR8_SPLIT, TR8_ITEMS);
    xcd_barrier(bar);
    const int NT = __builtin_amdgcn_readfirstlane(((const LAS int*)(lds + TAB_OFF))[32]);
    { pg8::Gemm g{(const pg8::bf16_t*)(a.ws + WS_H), (const pg8::bf16_t*)(a.ws + WS_W1T), NT * 256, 4096, DM / 2, (const int*)(a.ws + WS_ROWTOK)}; pg8::MoeOrder S; S.init(NT * 256, 4096, G, (int)blockIdx.x); S.tile_e = (const LAS int*)(lds + TAB_OFF) + 64;
      pg8::EpiSwiGLU E{a.ws + WS_ACT, (const float*)(a.ws + WS_B1P), 1.0f / W8_SCALE};
      pg8::gemm_phase<pg8::EpiSwiGLU, pg8::MoeOrder, true, true, true, true>(lds, g, S, E, wave); }
    xcd_barrier(bar);
    { pg8::Gemm g{(const pg8::bf16_t*)(a.ws + WS_ACT), (const pg8::bf16_t*)(a.ws + WS_W2T), NT * 256, 2048, FFE / 2, nullptr}; pg8::MoeOrder S; S.init(NT * 256, 2048, G, (int)blockIdx.x); S.tile_e = (const LAS int*)(lds + TAB_OFF) + 64;
      pg8::EpiMoeOut E{a.ws + WS_Y, a.b2, (const float*)(a.ws + WS_RGATE), 1.0f / W8_SCALE};
      pg8::gemm_phase<pg8::EpiMoeOut, pg8::MoeOrder, true, true, true>(lds, g, S, E, wave); }
    xcd_barrier(bar);
    p9_final(a, gw, NGW, LANE);
#undef TID
#undef LANE
}

extern "C" void kernel_launch(void* const* d_in, const int* in_sizes, int n_in, void* d_out, int out_size, void* d_ws, size_t ws_size, hipStream_t stream) {
    static int grid = 0;
    if (grid == 0) {
        if (n_in != 19 || out_size != NTOK * DM || ws_size < WS_END) { fprintf(stderr, "kernel_launch: unexpected problem (n_in %d, out %d, ws %zu)\n", n_in, out_size, ws_size); grid = -1; return; }
        int dev = 0, cus = 0, per_cu = 0;
        if (hipGetDevice(&dev) != hipSuccess || hipDeviceGetAttribute(&cus, hipDeviceAttributeMultiprocessorCount, dev) != hipSuccess) { grid = -1; return; }
        if (hipFuncSetAttribute((const void*)fwd, hipFuncAttributeMaxDynamicSharedMemorySize, LDS_BYTES) != hipSuccess) { fprintf(stderr, "kernel_launch: hipFuncSetAttribute failed\n"); grid = -1; return; }
        if (hipOccupancyMaxActiveBlocksPerMultiprocessor(&per_cu, (const void*)fwd, NWAVES * 64, LDS_BYTES) != hipSuccess || per_cu < 1) fprintf(stderr, "kernel_launch: occupancy query says %d\n", per_cu);
        (void)hipGetLastError();
        grid = cus;
    }
    if (grid < 0) return;
    if (hipMemsetAsync((char*)d_ws + WS_CTL, 0, CTL_ZERO_BYTES, stream) != hipSuccess) return;
    Args a{};
    a.x = (const float*)d_in[0]; a.c = (const float*)d_in[1]; a.pos = (const int*)d_in[2]; a.w_ada = (const float*)d_in[3]; a.b_ada = (const float*)d_in[4]; a.w_in = (const float*)d_in[5];
    a.hgrn_lb = (const float*)d_in[6]; a.gnorm_w = (const float*)d_in[7]; a.w_o = (const float*)d_in[8]; a.ln1_g = (const float*)d_in[9]; a.ln1_b = (const float*)d_in[10];
    a.router_w = (const float*)d_in[11]; a.router_b = (const float*)d_in[12]; a.w1 = (const float*)d_in[13]; a.b1 = (const float*)d_in[14]; a.w2 = (const float*)d_in[15]; a.b2 = (const float*)d_in[16];
    a.ln2_g = (const float*)d_in[17]; a.ln2_b = (const float*)d_in[18]; a.out = (float*)d_out; a.ws = (unsigned char*)d_ws;
    hipLaunchKernelGGL(fwd, dim3(grid), dim3(NWAVES * 64), LDS_BYTES, stream, a);
}
```

```cpp
#include <hip/hip_runtime.h>
#include <cstdio>
#include <cstdint>
__device__ __forceinline__ int fresh_lane() { int l; asm volatile("v_mbcnt_lo_u32_b32 %0, -1, 0\n\tv_mbcnt_hi_u32_b32 %0, -1, %0" : "=v"(l)); return l; }
__device__ __forceinline__ int wave_id() { return __builtin_amdgcn_readfirstlane(threadIdx.x >> 6); }
namespace pg8 {
#define PG8_LAS __attribute__((address_space(3)))
typedef unsigned short bf16_t;
typedef short bf16x8 __attribute__((ext_vector_type(8)));
typedef float f32x4 __attribute__((ext_vector_type(4)));
typedef unsigned u32x4 __attribute__((ext_vector_type(4)));
constexpr int ROWSLOT_OFF = 131072 + 4096;
constexpr int BM = 256, BK = 64, HALF = 128, HTB = HALF * BK * 2  , STAGE_BYTES = 8 * HTB, NXCD = 8, WGM = 8;

__host__ __device__ __forceinline__ int lds_byte(int r, int c) { const int st = (r >> 4) * 2 + (c >> 5), rr = r & 15, cc = c & 31, ob = rr * 64 + cc * 2; return st * 1024 + (ob ^ (((ob >> 9) & 1) << 5)); }
__host__ __device__ __forceinline__ void stage_rc(int b, int& R, int& C) { const int st = b / 1024, sb = b % 1024, swz = sb ^ (((sb >> 9) & 1) << 5); R = (st >> 1) * 16 + swz / 64; C = (st & 1) * 32 + (swz % 64) / 2; }
__host__ __device__ __forceinline__ int perm32(int rho) { const int n = rho >> 4, i = rho & 15; return 8 * (i >> 2) + 4 * n + (i & 3); }

struct Unit { int pm, pn, pb; };
struct Gemm { const bf16_t* A; const bf16_t* Bt; int M, N, K; const int* rowtok; };

struct StaticOrder {
    int nM, nN, nwg, G, c;
    __host__ __device__ void init(int M, int N, int G_, int c_) { nM = M / BM; nN = N / BM; nwg = nM * nN; G = G_; c = c_; }
    __host__ __device__ bool next(int i, Unit& u) const {
        const long L = (long)i * G + c; if (L >= nwg) return false;
        int wgid = (int)L; { const int q = nwg / NXCD, r = nwg % NXCD, xcd = wgid % NXCD, off = wgid / NXCD; wgid = (xcd < r ? xcd * (q + 1) : r * (q + 1) + (xcd - r) * q) + off; }
        const int nig = WGM * nN, gid = wgid / nig, fm = gid * WGM, gsz = (nM - fm) < WGM ? (nM - fm) : WGM;
        u.pm = fm + ((wgid % nig) % gsz); u.pn = (wgid % nig) / gsz; u.pb = u.pn; return true;
    }
    __device__ __forceinline__ void a_ready(const Unit&) const {}
    __device__ __forceinline__ void done(const Unit&) const {}
};

typedef int i32x4 __attribute__((ext_vector_type(4)));
typedef int i32x8 __attribute__((ext_vector_type(8)));
__device__ __forceinline__ i32x8 cat_i8(bf16x8 a, bf16x8 b) { return __builtin_shufflevector(__builtin_bit_cast(i32x4, a), __builtin_bit_cast(i32x4, b), 0, 1, 2, 3, 4, 5, 6, 7); }
__device__ __forceinline__ unsigned cvt_pk_bf16(float lo, float hi) { unsigned r; asm volatile("v_cvt_pk_bf16_f32 %0, %1, %2" : "=v"(r) : "v"(lo), "v"(hi)); return r; }

struct EpiStoreBf16 {
    static constexpr bool PERM = true, AFTER_DRAIN = false;
    bf16_t* O; int ldc;
    __device__ __forceinline__ void operator()(const f32x4 (&acc)[2][2][4][2], const Unit& u, int wr, int wc, int fr, int fq) const {
        const int row0 = u.pm * BM + wr * 64 + fr, col0 = u.pn * BM + wc * 32 + 8 * fq;
#pragma unroll
        for (int ai = 0; ai < 2; ++ai)
#pragma unroll
            for (int m = 0; m < 4; ++m) { bf16_t* rowp = O + (size_t)(row0 + ai * HALF + m * 16) * ldc + col0;
#pragma unroll
                for (int bj = 0; bj < 2; ++bj) { const f32x4 v0 = acc[ai][bj][m][0], v1 = acc[ai][bj][m][1];
                    u32x4 w; w.x = cvt_pk_bf16(v0[0], v0[1]); w.y = cvt_pk_bf16(v0[2], v0[3]); w.z = cvt_pk_bf16(v1[0], v1[1]); w.w = cvt_pk_bf16(v1[2], v1[3]);
                    *(u32x4*)(rowp + bj * HALF) = w; } }
    }
};
struct EpiProj {
    static constexpr bool PERM = true, AFTER_DRAIN = false;
    bf16_t* O; int ldc; const float* tab;
    __device__ __forceinline__ void operator()(const f32x4 (&acc)[2][2][4][2], const Unit& u, int wr, int wc, int fr, int fq) const {
        const int row0 = u.pm * BM + wr * 64 + fr, col0 = u.pn * BM + wc * 32 + 8 * fq;
        const bool rot = (u.pn < 8) && ((wc & 1) == 0); const float qs = (u.pn < 4) ? 0.18033688011112042f : 1.0f;
#pragma unroll
        for (int ai = 0; ai < 2; ++ai)
#pragma unroll
            for (int m = 0; m < 4; ++m) { const int row = row0 + ai * HALF + m * 16; bf16_t* rowp = O + (size_t)row * ldc + col0;
                f32x4 c0 = (f32x4){1.f, 1.f, 1.f, 1.f}, c1 = c0, s0 = (f32x4){0.f, 0.f, 0.f, 0.f}, s1 = s0;
                if (rot && fq < 2) { const float* tb = tab + (size_t)row * 16; c0 = *(const f32x4*)tb; c1 = *(const f32x4*)(tb + 4); s0 = *(const f32x4*)(tb + 8); s1 = *(const f32x4*)(tb + 12); if (fq == 0) { s0 = -s0; s1 = -s1; } }
#pragma unroll
                for (int bj = 0; bj < 2; ++bj) { f32x4 v0 = acc[ai][bj][m][0], v1 = acc[ai][bj][m][1];
                    if (rot) { f32x4 p0, p1;
#pragma unroll
                        for (int e = 0; e < 4; ++e) { p0[e] = __shfl_xor(v0[e], 16); p1[e] = __shfl_xor(v1[e], 16); }
                        v0 = v0 * c0 + p0 * s0; v1 = v1 * c1 + p1 * s1; }
                    v0 = v0 * qs; v1 = v1 * qs;
                    u32x4 w; w.x = cvt_pk_bf16(v0[0], v0[1]); w.y = cvt_pk_bf16(v0[2], v0[3]); w.z = cvt_pk_bf16(v1[0], v1[1]); w.w = cvt_pk_bf16(v1[2], v1[3]);
                    *(u32x4*)(rowp + bj * HALF) = w; }
                asm volatile("" ::: "memory"); }
    }
};
struct EpiSwiGLU {
    static constexpr bool PERM = true, AFTER_DRAIN = false;
    unsigned char* ACT; const float* b1p; float wscale;
    __device__ __forceinline__ void operator()(const f32x4 (&acc)[2][2][4][2], const Unit& u, int wr, int wc, int fr, int fq) const {
        const int row0 = u.pm * BM + wr * 64 + fr, hc0 = u.pn * HALF + wc * 32 + 8 * fq;
        const float* bp = b1p + (size_t)u.pb * BM + wc * 32 + 8 * fq;
        f32x4 bg[2], bl[2];
#pragma unroll
        for (int n = 0; n < 2; ++n) { bg[n] = *(const f32x4*)(bp + 4 * n); bl[n] = *(const f32x4*)(bp + HALF + 4 * n); }
#pragma unroll
        for (int ai = 0; ai < 2; ++ai)
#pragma unroll
            for (int m = 0; m < 4; ++m) { unsigned char* rowp = ACT + (size_t)(row0 + ai * HALF + m * 16) * 2048 + hc0; float r[8];
#pragma unroll
                for (int n = 0; n < 2; ++n) { const f32x4 g = acc[ai][0][m][n] * wscale + bg[n], l = acc[ai][1][m][n] * wscale + bl[n];
#pragma unroll
                    for (int j = 0; j < 4; ++j) { const float xg = fminf(g[j], 7.0f), xl = fminf(fmaxf(l[j], -7.0f), 7.0f);
                        r[4 * n + j] = xg * __builtin_amdgcn_rcpf(1.0f + __expf(-1.702f * xg)) * (xl + 1.0f); } }
                unsigned w0 = 0u, w1 = 0u;
                w0 = __builtin_amdgcn_cvt_pk_fp8_f32(r[0], r[1], w0, false); w0 = __builtin_amdgcn_cvt_pk_fp8_f32(r[2], r[3], w0, true);
                w1 = __builtin_amdgcn_cvt_pk_fp8_f32(r[4], r[5], w1, false); w1 = __builtin_amdgcn_cvt_pk_fp8_f32(r[6], r[7], w1, true);
                typedef unsigned u32x2 __attribute__((ext_vector_type(2))); *(u32x2*)rowp = (u32x2){w0, w1}; }
    }
};
struct EpiMoeOut {
    static constexpr bool PERM = true, AFTER_DRAIN = false;
    unsigned char* Y; const float* b2; const float* rgate; float wscale;
    __device__ __forceinline__ void operator()(const f32x4 (&acc)[2][2][4][2], const Unit& u, int wr, int wc, int fr, int fq) const {
        const int row0 = u.pm * BM + wr * 64 + fr, col0 = u.pn * BM + wc * 32 + 8 * fq;
        const float* bp = b2 + (size_t)(u.pb >> 3) * 2048 + col0;
        f32x4 bv[2][2];
#pragma unroll
        for (int bj = 0; bj < 2; ++bj)
#pragma unroll
            for (int n = 0; n < 2; ++n) bv[bj][n] = *(const f32x4*)(bp + bj * HALF + 4 * n);
#pragma unroll
        for (int ai = 0; ai < 2; ++ai)
#pragma unroll
            for (int m = 0; m < 4; ++m) { const int row = row0 + ai * HALF + m * 16; const float gt = rgate[row]; unsigned char* rowp = Y + (size_t)row * 2048 + col0;
#pragma unroll
                for (int bj = 0; bj < 2; ++bj) { const f32x4 v0 = (acc[ai][bj][m][0] * wscale + bv[bj][0]) * gt, v1 = (acc[ai][bj][m][1] * wscale + bv[bj][1]) * gt;
                    unsigned w0 = 0u, w1 = 0u; w0 = __builtin_amdgcn_cvt_pk_fp8_f32(v0[0], v0[1], w0, false); w0 = __builtin_amdgcn_cvt_pk_fp8_f32(v0[2], v0[3], w0, true);
                    w1 = __builtin_amdgcn_cvt_pk_fp8_f32(v1[0], v1[1], w1, false); w1 = __builtin_amdgcn_cvt_pk_fp8_f32(v1[2], v1[3], w1, true);
                    typedef unsigned u32x2 __attribute__((ext_vector_type(2))); *(u32x2*)(rowp + bj * HALF) = (u32x2){w0, w1}; } }
    }
};
struct MoeOrder : StaticOrder {
    const PG8_LAS int* tile_e;
    __device__ __forceinline__ bool next(int i, Unit& u) const { if (!StaticOrder::next(i, u)) return false; u.pm = __builtin_amdgcn_readfirstlane(tile_e[u.pm]); u.pb = (u.pm >> 5) * nN + u.pn; return true; }
};
template <class Epi, class Sched, bool ALIGN_EPI = false, bool SP2 = false, bool F8 = false, bool GATHER = false>
__device__ __forceinline__ void gemm_phase(PG8_LAS unsigned char* lds, const Gemm g, const Sched& S, const Epi& E, const int wave_in) {
    const int tid_ = wave_in * 64 + fresh_lane();
    const int tid = tid_, wid = __builtin_amdgcn_readfirstlane(tid >> 6), lane = tid & 63, wr = wid >> 2, wc = wid & 3, fr = lane & 15, fq = lane >> 4;
    const int K = g.K, nt = K / BK;
    unsigned voffA0, voffB0;
    { int R, C; stage_rc(tid * 16, R, C); const int Rb = Epi::PERM ? ((R & ~31) + perm32(R & 31)) : R; voffA0 = (unsigned)(R * K + C) * 2u; voffB0 = (unsigned)(Rb * K + C) * 2u; }
    const size_t pdelta = (size_t)64 * K * 2;
    const size_t kstep = (size_t)(BK * 2);
    const size_t hstep = (size_t)HALF * K * 2;
    const size_t tstep = 2 * hstep;
    const unsigned ldsw = (unsigned)wid * 1024u, lds0 = (unsigned)(uintptr_t)lds;
    const int aoff = lds_byte(wr * 64 + fr, fq * 8), boff = lds_byte(wc * 32 + fr, fq * 8);
#define PG8_SA(b, h) (((b) * 2 + (h)) * HTB)
#define PG8_SB(b, h) ((4 + (b) * 2 + (h)) * HTB)
#define PG8_STAGE1(bufoff, i_, gbase, v_) do { unsigned _keep; \
        asm volatile("s_mov_b32 %0, m0\n\ts_mov_b32 m0, %3\n\ts_nop 0\n\tglobal_load_lds_dwordx4 %1, %2\n\ts_mov_b32 m0, %0" : "=&s"(_keep) \
            : "v"(v_), "s"((const char*)(gbase)), "s"(lds0 + (unsigned)((bufoff) + (i_) * 8192) + ldsw) : "memory"); } while (0)
#define PG8_STAGE(bufoff, gbase, v0_) do { PG8_STAGE1(bufoff, 0, gbase, v0_); PG8_STAGE1(bufoff, 1, (const char*)(gbase) + pdelta, v0_); } while (0)
#define PG8_STAGE_A(bufoff, ptr, h) do { if constexpr (GATHER) { PG8_STAGE1(bufoff, 0, ptr, vAc[h][0]); PG8_STAGE1(bufoff, 1, ptr, vAc[h][1]); } \
        else { PG8_STAGE(bufoff, (ptr) + (h) * hstep, voffA0); } } while (0)
#define PG8_ROWS(u, v) do { _Pragma("unroll") for (int _h = 0; _h < 2; ++_h) _Pragma("unroll") for (int _i = 0; _i < 2; ++_i) { int R_, C_; stage_rc(tid * 16 + _i * 8192, R_, C_); \
        v[_h][_i] = (unsigned)g.rowtok[(u).pm * BM + _h * HALF + R_] * (unsigned)(K * 2) + (unsigned)(C_ * 2); } } while (0)
#define PG8_LDA(dst, b, h) do { _Pragma("unroll") for (int m = 0; m < 4; ++m) { if constexpr (F8) dst##8[m] = cat_i8(*(const PG8_LAS bf16x8*)(lds + PG8_SA(b, h) + aoff + m * 2048), *(const PG8_LAS bf16x8*)(lds + PG8_SA(b, h) + aoff + m * 2048 + 1024)); \
        else { _Pragma("unroll") for (int k = 0; k < 2; ++k) dst[m][k] = *(const PG8_LAS bf16x8*)(lds + PG8_SA(b, h) + aoff + m * 2048 + k * 1024); } } } while (0)
#define PG8_LDB(dst, b, h) do { _Pragma("unroll") for (int n = 0; n < 2; ++n) { if constexpr (F8) dst##8[n] = cat_i8(*(const PG8_LAS bf16x8*)(lds + PG8_SB(b, h) + boff + n * 2048), *(const PG8_LAS bf16x8*)(lds + PG8_SB(b, h) + boff + n * 2048 + 1024)); \
        else { _Pragma("unroll") for (int k = 0; k < 2; ++k) dst[n][k] = *(const PG8_LAS bf16x8*)(lds + PG8_SB(b, h) + boff + n * 2048 + k * 1024); } } } while (0)
#define PG8_MMA(ai, bj, At, Bt) do { __builtin_amdgcn_s_setprio(1); _Pragma("unroll") for (int m = 0; m < 4; ++m) _Pragma("unroll") for (int n = 0; n < 2; ++n) { \
        if constexpr (F8) { acc[ai][bj][m][n] = __builtin_amdgcn_mfma_scale_f32_16x16x128_f8f6f4(Bt##8[n], At##8[m], acc[ai][bj][m][n], 0, 0, 0, 0, 0, 0); } \
        else { _Pragma("unroll") for (int k = 0; k < 2; ++k) acc[ai][bj][m][n] = __builtin_amdgcn_mfma_f32_16x16x32_bf16(Bt[n][k], At[m][k], acc[ai][bj][m][n], 0, 0, 0); } } \
        __builtin_amdgcn_s_setprio(0); } while (0)
#define PG8_WAIT_V(n) asm volatile("s_waitcnt vmcnt(" #n ")" ::: "memory")
#define PG8_WAIT_L(n) asm volatile("s_waitcnt lgkmcnt(" #n ")" ::: "memory")
#define PG8_BAR __builtin_amdgcn_s_barrier()
#define PG8_SCHED __builtin_amdgcn_sched_barrier(0)
    Unit cur, nxt; int ui = 0;
    if (!S.next(0, cur)) return;
    f32x4 acc[2][2][4][2];
#pragma unroll
    for (int a = 0; a < 2; ++a)
#pragma unroll
        for (int b = 0; b < 2; ++b)
#pragma unroll
            for (int m = 0; m < 4; ++m)
#pragma unroll
                for (int n = 0; n < 2; ++n) acc[a][b][m][n] = (f32x4){0.f, 0.f, 0.f, 0.f};
    bf16x8 At[4][2], B0[2][2], B1[2][2]; i32x8 At8[4], B08[2], B18[2];
    const char* cA = (const char*)g.A + (GATHER ? (size_t)0 : (size_t)cur.pm * tstep); const char* cB = (const char*)g.Bt + (size_t)cur.pb * tstep;
    unsigned vAc[2][2];
    PG8_LAS u32x4* const rowslot = (PG8_LAS u32x4*)(lds + ROWSLOT_OFF) + tid;
    if constexpr (GATHER) { PG8_ROWS(cur, vAc); }
    S.a_ready(cur);
    if constexpr (SP2) {
        PG8_STAGE(PG8_SB(0, 0), cB, voffB0); PG8_STAGE(PG8_SB(0, 1), cB + hstep, voffB0); PG8_STAGE_A(PG8_SA(0, 0), cA, 0); PG8_STAGE_A(PG8_SA(0, 1), cA, 1);
        if (wr == 1) PG8_BAR;
        PG8_WAIT_V(2); PG8_BAR;
        PG8_STAGE(PG8_SB(1, 0), cB + kstep, voffB0); PG8_STAGE_A(PG8_SA(1, 0), cA + kstep, 0); PG8_STAGE(PG8_SB(1, 1), cB + hstep + kstep, voffB0);
        PG8_WAIT_V(6); PG8_BAR;
    } else {
        PG8_STAGE(PG8_SB(0, 0), cB, voffB0); PG8_STAGE_A(PG8_SA(0, 0), cA, 0); PG8_STAGE(PG8_SB(0, 1), cB + hstep, voffB0); PG8_STAGE_A(PG8_SA(0, 1), cA, 1);
        if (wr == 1) PG8_BAR;
        PG8_WAIT_V(4); PG8_BAR;
        PG8_STAGE(PG8_SB(1, 0), cB + kstep, voffB0); PG8_STAGE_A(PG8_SA(1, 0), cA + kstep, 0); PG8_STAGE(PG8_SB(1, 1), cB + hstep + kstep, voffB0);
        PG8_WAIT_V(6); PG8_BAR;
    }
    for (;;) {
        const bool has_next = S.next(ui + 1, nxt);
        if constexpr (GATHER) { if (has_next) { unsigned vAn[2][2]; PG8_ROWS(nxt, vAn); *rowslot = (u32x4){vAn[0][0], vAn[0][1], vAn[1][0], vAn[1][1]}; } }
        const char* nA = has_next ? (const char*)g.A + (GATHER ? (size_t)0 : (size_t)nxt.pm * tstep) : (GATHER ? (const char*)g.A : cA); const char* nB = has_next ? (const char*)g.Bt + (size_t)nxt.pb * tstep : cB;
        for (int t = 0; t < nt; t += 2) {
            const bool last = (t == nt - 2);
            const char* a1 = cA + (size_t)(t + 1) * kstep;
            const char* a2 = last ? nA : cA + (size_t)(t + 2) * kstep; const char* b2 = last ? nB : cB + (size_t)(t + 2) * kstep;
            const char* a3 = a2 + kstep; const char* b3 = b2 + kstep;
            if (last && has_next) S.a_ready(nxt);
            const bool nx = last && has_next;
            if constexpr (SP2) {
            PG8_LDB(B0, 0, 0); PG8_LDB(B1, 0, 1); PG8_SCHED; PG8_LDA(At, 0, 0); PG8_STAGE_A(PG8_SA(1, 1), a1, 1);
            if constexpr (GATHER) { if (nx) { const u32x4 rv = *rowslot; vAc[0][0] = rv.x; vAc[0][1] = rv.y; vAc[1][0] = rv.z; vAc[1][1] = rv.w; } }
            PG8_WAIT_V(8); PG8_WAIT_L(0); PG8_BAR; PG8_MMA(0, 0, At, B0); PG8_MMA(0, 1, At, B1); PG8_BAR; PG8_SCHED;
            PG8_LDA(At, 0, 1); PG8_STAGE(PG8_SB(0, 0), b2, voffB0); PG8_STAGE(PG8_SB(0, 1), b2 + hstep, voffB0); PG8_STAGE_A(PG8_SA(0, 0), a2, 0);
            PG8_WAIT_V(8); PG8_WAIT_L(0); PG8_BAR; PG8_MMA(1, 0, At, B0); PG8_MMA(1, 1, At, B1); PG8_BAR; PG8_SCHED;
            PG8_LDB(B0, 1, 0); PG8_LDB(B1, 1, 1); PG8_SCHED; PG8_LDA(At, 1, 0); PG8_STAGE_A(PG8_SA(0, 1), a2, 1);
            PG8_WAIT_V(8); PG8_WAIT_L(0); PG8_BAR; PG8_MMA(0, 0, At, B0); PG8_MMA(0, 1, At, B1); PG8_BAR; PG8_SCHED;
            PG8_LDA(At, 1, 1); PG8_STAGE(PG8_SB(1, 0), b3, voffB0); PG8_STAGE(PG8_SB(1, 1), b3 + hstep, voffB0); PG8_STAGE_A(PG8_SA(1, 0), a3, 0);
            PG8_WAIT_V(8); PG8_WAIT_L(0); PG8_BAR; PG8_MMA(1, 0, At, B0); PG8_MMA(1, 1, At, B1); PG8_BAR; PG8_SCHED;
            } else {
            PG8_LDB(B0, 0, 0); PG8_SCHED; PG8_LDA(At, 0, 0); PG8_STAGE_A(PG8_SA(1, 1), a1, 1);
            if constexpr (GATHER) { if (nx) { const u32x4 rv = *rowslot; vAc[0][0] = rv.x; vAc[0][1] = rv.y; vAc[1][0] = rv.z; vAc[1][1] = rv.w; } }
            PG8_WAIT_L(8); PG8_BAR; PG8_WAIT_L(0); PG8_MMA(0, 0, At, B0); PG8_BAR; PG8_SCHED;
            PG8_LDB(B1, 0, 1); PG8_STAGE(PG8_SB(0, 0), b2, voffB0);
            PG8_BAR; PG8_WAIT_L(0); PG8_MMA(0, 1, At, B1); PG8_BAR;
            PG8_LDA(At, 0, 1); PG8_STAGE_A(PG8_SA(0, 0), a2, 0);
            PG8_BAR; PG8_WAIT_L(0); PG8_MMA(1, 0, At, B0); PG8_BAR; PG8_SCHED;
            PG8_STAGE(PG8_SB(0, 1), b2 + hstep, voffB0);
            PG8_WAIT_V(6); PG8_BAR; PG8_MMA(1, 1, At, B1); PG8_BAR;
            PG8_LDB(B0, 1, 0); PG8_SCHED; PG8_LDA(At, 1, 0); PG8_STAGE_A(PG8_SA(0, 1), a2, 1);
            PG8_WAIT_L(8); PG8_BAR; PG8_WAIT_L(0); PG8_MMA(0, 0, At, B0); PG8_BAR; PG8_SCHED;
            PG8_LDB(B1, 1, 1); PG8_STAGE(PG8_SB(1, 0), b3, voffB0);
            PG8_BAR; PG8_WAIT_L(0); PG8_MMA(0, 1, At, B1); PG8_BAR;
            PG8_LDA(At, 1, 1); PG8_STAGE_A(PG8_SA(1, 0), a3, 0);
            PG8_BAR; PG8_WAIT_L(0); PG8_MMA(1, 0, At, B0); PG8_BAR; PG8_SCHED;
            PG8_STAGE(PG8_SB(1, 1), b3 + hstep, voffB0);
            PG8_WAIT_V(6); PG8_BAR; PG8_MMA(1, 1, At, B1); PG8_BAR;
            }
        }
        if constexpr (ALIGN_EPI) { if (wr == 0) PG8_BAR; }
        if constexpr (!Epi::AFTER_DRAIN) { const int le = fresh_lane(); E(acc, cur, wr, wc, le & 15, le >> 4); S.done(cur); }
        if (!has_next) break;
#pragma unroll
        for (int a = 0; a < 2; ++a)
#pragma unroll
            for (int b = 0; b < 2; ++b)
#pragma unroll
                for (int m = 0; m < 4; ++m)
#pragma unroll
                    for (int n = 0; n < 2; ++n) acc[a][b][m][n] = (f32x4){0.f, 0.f, 0.f, 0.f};
        cur = nxt; cA = nA; cB = nB; ++ui;

        if constexpr (ALIGN_EPI) { if (wr == 1) PG8_BAR; }
    }
    PG8_WAIT_V(0);
    if constexpr (!ALIGN_EPI) { if (wr == 0) PG8_BAR; }
    PG8_BAR;
    if constexpr (Epi::AFTER_DRAIN) { E.fused(acc, cur, wr, wc, fr, fq, lds, wid, lane); S.done(cur); }
#undef PG8_SA
#undef PG8_SB
#undef PG8_STAGE
#undef PG8_LDA
#undef PG8_STAGE_A
#undef PG8_STAGE1
#undef PG8_ROWS
#undef PG8_LDB
#undef PG8_MMA
#undef PG8_WAIT_V
#undef PG8_WAIT_L
#undef PG8_BAR
#undef PG8_SCHED
}
}

constexpr int NB = 4, SEQ = 2048, DM = 2048, NTOK = NB * SEQ;
constexpr int NIN = 7168;
constexpr int NEXP = 32, FFE = 2048;
constexpr int MAXROWS = 40960;
constexpr float ALPHA_DN = 1.189207115002721f;
constexpr int NWAVES = 8;
constexpr size_t MiB = 1u << 20;
constexpr size_t WS_CTL = 0, CTL_ZERO_BYTES = 2 * MiB;
constexpr size_t WS_ROWTOK = 1 * MiB;
constexpr size_t WS_MOD = 7 * MiB, WS_TAB = 2 * MiB, WS_B1P = 3 * MiB, WS_ASG = 4 * MiB, WS_RGATE = 5 * MiB, WS_RWT = 6 * MiB;
constexpr size_t WS_WINT = 8 * MiB, WS_WOT = 36 * MiB, WS_W1T = 64 * MiB, WS_W2T = 576 * MiB;
constexpr size_t WS_H = 832 * MiB, WS_PROJ = 864 * MiB, WS_ORAW = 976 * MiB, WS_MIXED = 1008 * MiB, WS_MIXF = 1040 * MiB, WS_X1 = 1104 * MiB;
constexpr size_t WS_XG = 1168 * MiB, WS_OBR = 1328 * MiB, WS_ACT = 1664 * MiB, WS_Y = 2176 * MiB, WS_END = 2688 * MiB;
constexpr int ECAP = 8192, ETILES = ECAP / 256;
constexpr size_t WS_HIMG = WS_XG, WS_HSC = WS_XG + 64 * MiB;
constexpr size_t WS_OB = WS_OBR, WS_LSE = WS_OBR + 64 * MiB;
constexpr int CW_TMO = 0, CW_QUEUE = 32  , CW_CNT = 64  , CW_BAR = 4096, CW_BAR2 = 8192;
constexpr int RING_BYTES = 131072, LDSCTL_OFF = RING_BYTES, MISC_OFF = LDSCTL_OFF + 320, TAB_OFF = LDSCTL_OFF + 1024;
constexpr int LDS_BYTES = 147456;

#define GAS __attribute__((address_space(1)))
#define LAS __attribute__((address_space(3)))
typedef unsigned short bf16;
typedef unsigned v4u __attribute__((ext_vector_type(4)));
typedef unsigned v2u __attribute__((ext_vector_type(2)));
typedef float f32x4 __attribute__((ext_vector_type(4)));
typedef GAS unsigned gu32;
#define RLX_AGENT __ATOMIC_RELAXED, __HIP_MEMORY_SCOPE_AGENT
#define LDS_WAIT() asm volatile("s_waitcnt lgkmcnt(0)" ::: "memory")
#define VM_WAIT() asm volatile("s_waitcnt vmcnt(0)" ::: "memory")
__device__ __forceinline__ unsigned f2bf(float f) { unsigned u = __builtin_bit_cast(unsigned, f); return (u + 0x7fffu + ((u >> 16) & 1u)) >> 16; }
__device__ __forceinline__ unsigned pk2(float lo, float hi) { return f2bf(lo) | (f2bf(hi) << 16); }
__device__ __forceinline__ float bflo(unsigned w) { return __builtin_bit_cast(float, w << 16); }
__device__ __forceinline__ float bfhi(unsigned w) { return __builtin_bit_cast(float, w & 0xffff0000u); }
__device__ __forceinline__ f32x4 ldg4(const void* ubase, unsigned voff) { return *(const GAS f32x4*)((const GAS unsigned char*)ubase + voff); }
__device__ __forceinline__ void stg4(void* ubase, unsigned voff, f32x4 v) { *(GAS f32x4*)((GAS unsigned char*)ubase + voff) = v; }
__device__ __forceinline__ v2u ldg2(const void* ubase, unsigned voff) { return *(const GAS v2u*)((const GAS unsigned char*)ubase + voff); }
__device__ __forceinline__ float wave_sum(float v) {
#pragma unroll
    for (int o = 1; o < 64; o <<= 1) v += __shfl_xor(v, o);
    return v;
}
#define XB_TMO      128
#define XB_XCNT(j)  (256  + 64 * (j))
#define XB_XSUB(j)  (1280 + 64 * (j))
#define XB_XGEN(j)  (2304 + 64 * (j))
#define XB_TOP      3328
#define XB_TOPGEN   3392
#define XCD_BAR_WORDS 3456
#define XB_SPIN_CAP (1u << 18)

__device__ __forceinline__ unsigned xb_ld(unsigned* p)              { return __hip_atomic_load(p, __ATOMIC_RELAXED, __HIP_MEMORY_SCOPE_AGENT); }
__device__ __forceinline__ unsigned xb_add(unsigned* p, unsigned v) { return __hip_atomic_fetch_add(p, v, __ATOMIC_RELAXED, __HIP_MEMORY_SCOPE_AGENT); }
__device__ __forceinline__ unsigned xb_xcc_id() { return (unsigned)__builtin_amdgcn_s_getreg((3 << 11) | 20) & 0xFu; }
#define XB_SPIN(cond, bar) do { unsigned _sp = 0; while (cond) { __builtin_amdgcn_s_sleep(1); \
    if ((++_sp & 255u) == 0u) { if (xb_ld(&(bar)[XB_TMO])) break; if (_sp > XB_SPIN_CAP) { atomicAdd(&(bar)[XB_TMO], 1u); break; } } } } while (0)

struct XcdBarrier {
    int wave; unsigned G;
    unsigned* bar; unsigned x;
    volatile LAS unsigned* st;
};

__device__ __forceinline__ XcdBarrier xcd_barrier_post(unsigned* bar, volatile LAS unsigned* st, int wave, unsigned G) {
    XcdBarrier b; b.wave = wave; b.G = G; b.bar = bar; b.x = xb_xcc_id(); b.st = st;
    if (wave == 0 && fresh_lane() == 0) (void)xb_add(&bar[XB_XCNT(b.x)], 1u);
    return b;
}
__device__ __forceinline__ void xcd_barrier_complete(unsigned* bar, unsigned x, unsigned& nloc, unsigned& nx, const unsigned G) {
    unsigned sum, cnt, mine, sp = 0u;
    for (;;) {
        sum = 0u; cnt = 0u; mine = 0u;
#pragma unroll
        for (unsigned j = 0; j < 16; ++j) { const unsigned c = xb_ld(&bar[XB_XCNT(j)]); sum += c; cnt += (c > 0u) ? 1u : 0u; mine = (j == x) ? c : mine; }
        if (sum == G) break;
        __builtin_amdgcn_s_sleep(1);
        if ((++sp & 255u) == 0u) { if (xb_ld(&bar[XB_TMO])) break; if (sp > XB_SPIN_CAP) { atomicAdd(&bar[XB_TMO], 1u); break; } }
    }
    nloc = mine > 0u ? mine : 1u; nx = cnt > 0u ? cnt : 1u;
}

__device__ __forceinline__ void xcd_barrier(const XcdBarrier& b) {
    asm volatile("s_waitcnt vmcnt(0)" ::: "memory");
    __syncthreads();
    if (b.wave == 0 && fresh_lane() == 0) {
        unsigned* bar = b.bar;
        __builtin_amdgcn_s_waitcnt(0);
        unsigned nloc = b.st[0], nx = b.st[1];
        if (nloc == 0u) { xcd_barrier_complete(bar, b.x, nloc, nx, b.G); b.st[0] = nloc; b.st[1] = nx; }
        const unsigned old = xb_add(&bar[XB_XSUB(b.x)], 1u);
        const unsigned gen = old / nloc;
        if (old + 1u == (gen + 1u) * nloc) {
            __builtin_amdgcn_fence(__ATOMIC_RELEASE, "agent");
            asm volatile("s_waitcnt vmcnt(0)" ::: "memory");
            const unsigned og = xb_add(&bar[XB_TOP], 1u);
            const unsigned tg = og / nx;
            if (og + 1u == (tg + 1u) * nx) xb_add(&bar[XB_TOPGEN], 1u);
            else XB_SPIN(xb_ld(&bar[XB_TOPGEN]) == tg, bar);
            __builtin_amdgcn_fence(__ATOMIC_ACQUIRE, "agent");
            xb_add(&bar[XB_XGEN(b.x)], 1u);
            asm volatile("s_waitcnt vmcnt(0)" ::: "memory");
        } else {
            XB_SPIN(xb_ld(&bar[XB_XGEN(b.x)]) == gen, bar);
            __builtin_amdgcn_fence(__ATOMIC_ACQUIRE, "agent");
            asm volatile("s_waitcnt vmcnt(0)" ::: "memory");
        }
    }
    __syncthreads();
}

struct Args {
    const float* x; const float* c; const int* pos; const float* w_ada; const float* b_ada; const float* w_in; const float* hgrn_lb; const float* gnorm_w;
    const float* w_o; const float* ln1_g; const float* ln1_b; const float* router_w; const float* router_b; const float* w1; const float* b1; const float* w2;
    const float* b2; const float* ln2_g; const float* ln2_b; float* out; unsigned char* ws;
};

__device__ __forceinline__ void p0_mod(const Args& a, LAS unsigned char* lds, int tid, int blk, int nblk) {
    LAS float* sc = (LAS float*)lds;
    LAS float* part = (LAS float*)(lds + 32768);
    for (int i = tid; i < NB * DM; i += 512) { const float v = a.c[i]; sc[i] = v / (1.0f + __expf(-v)); }
    __syncthreads();
    for (int bx = blk; bx < 192; bx += nblk) {
        __syncthreads();
        const int cg = tid & 15, ks = tid >> 4;
        const float* wp = a.w_ada + (size_t)(ks * 64) * 12288 + bx * 64 + cg * 4;
        f32x4 acc[4];
#pragma unroll
        for (int b = 0; b < 4; ++b) acc[b] = (f32x4){0.f, 0.f, 0.f, 0.f};
#pragma unroll 8
        for (int kk = 0; kk < 64; ++kk) { const f32x4 w = *(const f32x4*)(wp + (size_t)kk * 12288);
#pragma unroll
            for (int b = 0; b < 4; ++b) acc[b] += w * sc[b * DM + ks * 64 + kk]; }
#pragma unroll
        for (int b = 0; b < 4; ++b) *(LAS f32x4*)(part + (ks * 4 + b) * 64 + cg * 4) = acc[b];
        __syncthreads();
        if (tid < 256) { const int b = tid >> 6, col = tid & 63; float s = a.b_ada[bx * 64 + col];
            for (int k = 0; k < 32; ++k) s += part[(k * 4 + b) * 64 + col];
            ((float*)(a.ws + WS_MOD))[b * 12288 + bx * 64 + col] = s; }
    }
    __syncthreads();
}
struct TrIt { const float* src; bf16* dst; int N; int nn0; int perm; };
__device__ __forceinline__ TrIt tr_decode(const Args& a, int it, int lane) {
    constexpr int I_IN = 32 * (NIN / 32), I_O = 32 * (DM / 32), I_1 = 32 * (4096 / 32), I_2 = 32 * (2048 / 32);
    const int nq = lane & 7, ko = lane >> 3; int r = it, nblk; const float* W; bf16* WT; TrIt t; t.perm = 0;
    if (r < I_IN) { W = a.w_in; t.N = NIN; WT = (bf16*)(a.ws + WS_WINT); nblk = NIN / 32; }
    else if ((r -= I_IN) < I_O) { W = a.w_o; t.N = DM; WT = (bf16*)(a.ws + WS_WOT); nblk = DM / 32; }
    else if ((r -= I_O) < NEXP * I_1) { const int e = r / I_1; r -= e * I_1; W = a.w1 + (size_t)e * 2048 * 4096; t.N = 4096; WT = (bf16*)(a.ws + WS_W1T) + (size_t)e * 4096 * 2048; nblk = 128; t.perm = 1; }
    else { r -= NEXP * I_1; const int e = r / I_2; r -= e * I_2; W = a.w2 + (size_t)e * 2048 * 2048; t.N = 2048; WT = (bf16*)(a.ws + WS_W2T) + (size_t)e * 2048 * 2048; nblk = 64; }
    const int kb = r / nblk, nb = r - kb * nblk;
    t.nn0 = 32 * nb + 4 * nq; t.src = W + (size_t)(64 * kb + 8 * ko) * t.N + t.nn0; t.dst = WT + 64 * kb + 8 * ko;
    return t;
}
constexpr int TR_ITEMS_DENSE = 32 * (NIN / 32) + 32 * (DM / 32);
__device__ __forceinline__ void tr_load(const TrIt& t, f32x4 (&r)[8]) {
#pragma unroll
    for (int i = 0; i < 8; ++i) r[i] = __builtin_nontemporal_load((const GAS f32x4*)(t.src + (size_t)i * t.N));
}
__device__ __forceinline__ void tr_store(const TrIt& t, const f32x4 (&r)[8]) {
#pragma unroll
    for (int j = 0; j < 4; ++j) { const int nn = t.nn0 + j; const int drow = t.perm ? ((((nn >> 1) >> 7) << 8) + ((nn >> 1) & 127) + ((nn & 1) << 7)) : nn;
        v4u o; o.x = pg8::cvt_pk_bf16(r[0][j], r[1][j]); o.y = pg8::cvt_pk_bf16(r[2][j], r[3][j]); o.z = pg8::cvt_pk_bf16(r[4][j], r[5][j]); o.w = pg8::cvt_pk_bf16(r[6][j], r[7][j]);
        *(GAS v4u*)(t.dst + (size_t)drow * 2048) = o; }
}
__device__ __forceinline__ void p0_weights(const Args& a, int gw, int NGW, int lane, const int it0, const int NITEMS) {
    f32x4 r0[8], r1[8], r2[8], r3[8]; TrIt t0, t1, t2, t3; int it = it0 + gw;
    if (it < NITEMS) { t0 = tr_decode(a, it, lane); tr_load(t0, r0); }
    if (it + NGW < NITEMS) { t1 = tr_decode(a, it + NGW, lane); tr_load(t1, r1); }
    if (it + 2 * NGW < NITEMS) { t2 = tr_decode(a, it + 2 * NGW, lane); tr_load(t2, r2); }
    if (it + 3 * NGW < NITEMS) { t3 = tr_decode(a, it + 3 * NGW, lane); tr_load(t3, r3); }
    while (it < NITEMS) {
        tr_store(t0, r0); if (it + 4 * NGW < NITEMS) { t0 = tr_decode(a, it + 4 * NGW, lane); tr_load(t0, r0); }
        if (it + NGW < NITEMS) { tr_store(t1, r1); if (it + 5 * NGW < NITEMS) { t1 = tr_decode(a, it + 5 * NGW, lane); tr_load(t1, r1); } }
        if (it + 2 * NGW < NITEMS) { tr_store(t2, r2); if (it + 6 * NGW < NITEMS) { t2 = tr_decode(a, it + 6 * NGW, lane); tr_load(t2, r2); } }
        if (it + 3 * NGW < NITEMS) { tr_store(t3, r3); if (it + 7 * NGW < NITEMS) { t3 = tr_decode(a, it + 7 * NGW, lane); tr_load(t3, r3); } }
        it += 4 * NGW; }
}
constexpr float W8_SCALE = 64.0f;
constexpr int TR8_I1 = 16 * (4096 / 32), TR8_I2 = 16 * (2048 / 32), TR8_ITEMS = NEXP * TR8_I1 + NEXP * TR8_I2;
constexpr int TR8_SPLIT = (int)(TR8_ITEMS * 1.0);
struct Tr8 { const float* src; unsigned char* dst; int N; int nn0; int perm; };
__device__ __forceinline__ Tr8 tr8_decode(const Args& a, int it, int lane) {
    const int nq = lane & 7, ko = lane >> 3; int r = it, nblk; const float* W; unsigned char* WT; Tr8 t;
    if (r < NEXP * TR8_I1) { const int e = r / TR8_I1; r -= e * TR8_I1; W = a.w1 + (size_t)e * 2048 * 4096; t.N = 4096; WT = a.ws + WS_W1T + (size_t)e * 4096 * 2048; nblk = 128; t.perm = 1; }
    else { r -= NEXP * TR8_I1; const int e = r / TR8_I2; r -= e * TR8_I2; W = a.w2 + (size_t)e * 2048 * 2048; t.N = 2048; WT = a.ws + WS_W2T + (size_t)e * 2048 * 2048; nblk = 64; t.perm = 0; }
    const int kb = r / nblk, nb = r - kb * nblk;
    t.nn0 = 32 * nb + 4 * nq; t.src = W + (size_t)(128 * kb + 16 * ko) * t.N + t.nn0; t.dst = WT + 128 * kb + 16 * ko;
    return t;
}
__device__ __forceinline__ void tr8_load(const Tr8& t, f32x4 (&r)[16]) {
#pragma unroll
    for (int i = 0; i < 16; ++i) r[i] = __builtin_nontemporal_load((const GAS f32x4*)(t.src + (size_t)i * t.N));
}
__device__ __forceinline__ void tr8_store(const Tr8& t, const f32x4 (&r)[16]) {
#pragma unroll
    for (int j = 0; j < 4; ++j) { const int nn = t.nn0 + j; const int drow = t.perm ? ((((nn >> 1) >> 7) << 8) + ((nn >> 1) & 127) + ((nn & 1) << 7)) : nn;
        unsigned d[4];
#pragma unroll
        for (int q = 0; q < 4; ++q) { unsigned w = 0u; w = __builtin_amdgcn_cvt_pk_fp8_f32(r[4 * q][j] * W8_SCALE, r[4 * q + 1][j] * W8_SCALE, w, false);
            w = __builtin_amdgcn_cvt_pk_fp8_f32(r[4 * q + 2][j] * W8_SCALE, r[4 * q + 3][j] * W8_SCALE, w, true); d[q] = w; }
        v4u o; o.x = d[0]; o.y = d[1]; o.z = d[2]; o.w = d[3];
        *(GAS v4u*)(t.dst + (size_t)drow * 2048) = o; }
}
__device__ __forceinline__ void conv8_weights(const Args& a, int gw, int NGW, int lane, const int it0, const int NITEMS) {
    f32x4 r0[16], r1[16]; Tr8 t0, t1; int it = it0 + gw;
    if (it < NITEMS) { t0 = tr8_decode(a, it, lane); tr8_load(t0, r0); }
    if (it + NGW < NITEMS) { t1 = tr8_decode(a, it + NGW, lane); tr8_load(t1, r1); }
    while (it < NITEMS) {
        tr8_store(t0, r0); if (it + 2 * NGW < NITEMS) { t0 = tr8_decode(a, it + 2 * NGW, lane); tr8_load(t0, r0); }
        if (it + NGW < NITEMS) { tr8_store(t1, r1); if (it + 3 * NGW < NITEMS) { t1 = tr8_decode(a, it + 3 * NGW, lane); tr8_load(t1, r1); } }
        it += 2 * NGW; }
}
__device__ __forceinline__ void conv8_weights_dyn(const Args& a, int lane, const int NITEMS) {
    gu32* q = (gu32*)(a.ws + WS_CTL) + CW_QUEUE;
    f32x4 r0[16], r1[16]; Tr8 t0, t1; t0.src = nullptr; t1.src = nullptr;
    unsigned gv = 0u, gn = 0u;
    if (lane == 0) gv = __hip_atomic_fetch_add(q, 4u, RLX_AGENT);
    if (lane == 0) gn = __hip_atomic_fetch_add(q, 4u, RLX_AGENT);
    int cb = __builtin_amdgcn_readfirstlane((int)gv), k = 0;
    int i0 = cb + 0, i1 = cb + 1; k = 2;
    if (i0 < NITEMS) { t0 = tr8_decode(a, i0, lane); tr8_load(t0, r0); }
    if (i1 < NITEMS) { t1 = tr8_decode(a, i1, lane); tr8_load(t1, r1); }
    while (i0 < NITEMS || i1 < NITEMS) {
        if (i0 < NITEMS) tr8_store(t0, r0);
        if (k == 4) { cb = __builtin_amdgcn_readfirstlane((int)gn); k = 0; if (lane == 0) gn = __hip_atomic_fetch_add(q, 4u, RLX_AGENT); }
        i0 = cb + k++; if (i0 < NITEMS) { t0 = tr8_decode(a, i0, lane); tr8_load(t0, r0); }
        if (i1 < NITEMS) tr8_store(t1, r1);
        if (k == 4) { cb = __builtin_amdgcn_readfirstlane((int)gn); k = 0; if (lane == 0) gn = __hip_atomic_fetch_add(q, 4u, RLX_AGENT); }
        i1 = cb + k++; if (i1 < NITEMS) { t1 = tr8_decode(a, i1, lane); tr8_load(t1, r1); }
    }
}
__device__ __forceinline__ void p0_small(const Args& a, int gw, int NGW, int lane) {
    float* b1p = (float*)(a.ws + WS_B1P);
    for (int i = gw * 64 + lane; i < NEXP * 4096; i += NGW * 64) { const int e = i >> 12, nn = i & 4095; const int drow = (((nn >> 1) >> 7) << 8) + ((nn >> 1) & 127) + ((nn & 1) << 7); b1p[e * 4096 + drow] = a.b1[i]; }
    bf16* rwh = (bf16*)(a.ws + WS_RWT); bf16* rwl = rwh + NEXP * DM;
    for (int i = gw * 64 + lane; i < NEXP * DM; i += NGW * 64) { const int e = i >> 11, col = i & 2047; const float w = a.router_w[col * 32 + e]; const unsigned hb = f2bf(w); rwh[i] = (bf16)hb; rwl[i] = (bf16)f2bf(w - __builtin_bit_cast(float, hb << 16)); }
}

__device__ __forceinline__ void p1_h(const Args& a, int gw, int NGW, int lane) {
    const float* MOD = (const float*)(a.ws + WS_MOD); bf16* H = (bf16*)(a.ws + WS_H);
    const unsigned vo = (unsigned)lane * 16u, vh = (unsigned)lane * 8u;
    for (int row = gw; row < NTOK; row += NGW) { const int b = row >> 11; const float* mb = MOD + b * 12288; const float* xr = a.x + (size_t)row * DM; bf16* hr = H + (size_t)row * DM;
#pragma unroll
        for (int j = 0; j < 8; ++j) { const f32x4 v = ldg4(xr + 256 * j, vo), sh = ldg4(mb + 256 * j, vo), sc = ldg4(mb + 2048 + 256 * j, vo); const f32x4 h = v * (sc + 1.0f) + sh;
            v2u w; w.x = pk2(h[0], h[1]); w.y = pk2(h[2], h[3]); *(GAS v2u*)((GAS unsigned char*)(hr + 256 * j) + vh) = w; } }
    float* TAB = (float*)(a.ws + WS_TAB);
    for (int i = gw * 64 + lane; i < NTOK * 8; i += NGW * 64) { const int tok = i >> 3, f = i & 7;
        const float inv = powf(500000.0f, -(float)f * 0.125f); const float ang = (float)a.pos[tok] * inv;
        double rev = (double)ang * 0.15915494309189535; rev -= floor(rev); const float r = (float)rev;
        TAB[tok * 16 + f] = __builtin_amdgcn_cosf(r); TAB[tok * 16 + 8 + f] = __builtin_amdgcn_sinf(r); }
}

typedef short bf16x8v __attribute__((ext_vector_type(8)));
typedef short s16x4v __attribute__((ext_vector_type(4)));
__device__ __forceinline__ void unpack8(const v4u w, float (&t)[8]) { t[0] = bflo(w.x); t[1] = bfhi(w.x); t[2] = bflo(w.y); t[3] = bfhi(w.y); t[4] = bflo(w.z); t[5] = bfhi(w.z); t[6] = bflo(w.w); t[7] = bfhi(w.w); }
__device__ __forceinline__ v4u pack8(const float (&t)[8]) { v4u w; w.x = pk2(t[0], t[1]); w.y = pk2(t[2], t[3]); w.z = pk2(t[4], t[5]); w.w = pk2(t[6], t[7]); return w; }
__device__ __forceinline__ void glds16(const void* gsrc, unsigned lds_dst) { unsigned keep;
    asm volatile("s_mov_b32 %0, m0\n\ts_mov_b32 m0, %2\n\ts_nop 0\n\tglobal_load_lds_dwordx4 %1, off\n\ts_mov_b32 m0, %0" : "=&s"(keep) : "v"(gsrc), "s"(lds_dst) : "memory"); }
struct AttnU { int b, h, br, d, r, n; };
__device__ __forceinline__ AttnU attn_decode(int unit) { AttnU u; const int bh = unit / 48, x = unit - bh * 48; u.b = bh >> 4; u.h = bh & 15;
    if (x < 16) { u.br = 0; u.d = 1; u.r = 0; u.n = x; } else if (x < 32) { u.br = 1; u.d = 4; u.r = (x - 16) >> 2; u.n = (x - 16) & 3; } else { u.br = 2; u.d = 16; u.r = x - 32; u.n = 0; } return u; }
__device__ __forceinline__ void attn_issue(const Args& a, unsigned lds0, int bo, const AttnU& u, int wave, int lane) {
    const bf16* PROJ = (const bf16*)(a.ws + WS_PROJ);
#pragma unroll
    for (int j = 0; j < 4; ++j) { const int ri = wave + 8 * j, kl = 8 * ri + (lane >> 3), cp = lane & 7;
        if (u.n > 0 || ri >= 16) {
            const size_t tok = (size_t)u.b * SEQ + ((u.n - 1) * 128 + kl) * u.d + u.r; const int f = (kl >> 1) & 7;
            const bf16* kp = PROJ + tok * NIN + 1024 + u.h * 64 + 8 * (cp ^ f);
            const bf16* vp = PROJ + tok * NIN + 2048 + u.h * 64 + 8 * ((((cp >> 1) ^ (f & 3)) << 1) | (cp & 1));
            glds16(kp, (unsigned)__builtin_amdgcn_readfirstlane((int)(lds0 + bo + ri * 1024)));
            glds16(vp, (unsigned)__builtin_amdgcn_readfirstlane((int)(lds0 + bo + 32768 + ri * 1024))); } }
}
__device__ __forceinline__ void attn_compute(const Args& a, LAS unsigned char* lds, int bo, const AttnU& u, int w, int lane, bf16x8v bq0, bf16x8v bq1) {
    bf16* OB = (bf16*)(a.ws + WS_OB); float* LSE = (float*)(a.ws + WS_LSE);
    const int ql = lane & 15, g = lane >> 4, n = u.n; const int KL = bo, VL = bo + 32768;
    const int qstep = n * 128 + 16 * w + ql; const size_t qtok = (size_t)u.b * SEQ + qstep * u.d + u.r;
    f32x4 sc[9];
#pragma unroll
    for (int tt = 0; tt < 9; ++tt) { const int t = w + tt;
        if (n > 0 || t >= 8) { const int kl = 16 * t + ql, f = (kl >> 1) & 7;
            const bf16x8v ka = *(const LAS bf16x8v*)(lds + KL + kl * 128 + ((g ^ f) << 4)), kb = *(const LAS bf16x8v*)(lds + KL + kl * 128 + (((g + 4) ^ f) << 4));
            f32x4 acc = (f32x4){0.f, 0.f, 0.f, 0.f};
            acc = __builtin_amdgcn_mfma_f32_16x16x32_bf16(ka, bq0, acc, 0, 0, 0); acc = __builtin_amdgcn_mfma_f32_16x16x32_bf16(kb, bq1, acc, 0, 0, 0);
            if (tt == 0) {
#pragma unroll
                for (int e = 0; e < 4; ++e) if (4 * g + e < ql) acc[e] = -1e30f; }
            if (tt == 8) {
#pragma unroll
                for (int e = 0; e < 4; ++e) if (4 * g + e > ql) acc[e] = -1e30f; }
            sc[tt] = acc;
        } else sc[tt] = (f32x4){-1e30f, -1e30f, -1e30f, -1e30f}; }
    float mx = -1e30f;
#pragma unroll
    for (int tt = 0; tt < 9; ++tt) mx = fmaxf(fmaxf(mx, fmaxf(sc[tt][0], sc[tt][1])), fmaxf(sc[tt][2], sc[tt][3]));
    mx = fmaxf(mx, __shfl_xor(mx, 16)); mx = fmaxf(mx, __shfl_xor(mx, 32));
    float lsum = 0.f;
#pragma unroll
    for (int tt = 0; tt < 9; ++tt)
#pragma unroll
        for (int e = 0; e < 4; ++e) { const float p = __builtin_amdgcn_exp2f(sc[tt][e] - mx); sc[tt][e] = p; lsum += p; }
    lsum += __shfl_xor(lsum, 16); lsum += __shfl_xor(lsum, 32);
    f32x4 o[4];
#pragma unroll
    for (int db = 0; db < 4; ++db) o[db] = (f32x4){0.f, 0.f, 0.f, 0.f};
    const int rq = ql >> 2, rp = ql & 3;
#pragma unroll
    for (int i = 0; i < 5; ++i) { const int t0 = w + 2 * i, t1 = w + 2 * i + 1;
        if (n > 0 || t1 >= 8 || (i == 4)) {
            const bool e0 = (n > 0 || t0 >= 8), e1 = (i < 4) && (n > 0 || t1 >= 8);
            const int ta0 = e0 ? t0 : 8, ta1 = e1 ? t1 : 8;
            v4u pw; pw.x = e0 ? pk2(sc[2 * i][0], sc[2 * i][1]) : 0u; pw.y = e0 ? pk2(sc[2 * i][2], sc[2 * i][3]) : 0u;
            if (i < 4) { pw.z = e1 ? pk2(sc[2 * i + 1][0], sc[2 * i + 1][1]) : 0u; pw.w = e1 ? pk2(sc[2 * i + 1][2], sc[2 * i + 1][3]) : 0u; } else { pw.z = 0u; pw.w = 0u; }
            const bf16x8v pf = __builtin_bit_cast(bf16x8v, pw);
            const int k0 = 16 * ta0 + 4 * g + rq, k1 = 16 * ta1 + 4 * g + rq, f0 = (k0 >> 1) & 3, f1 = (k1 >> 1) & 3;
#pragma unroll
            for (int db = 0; db < 4; ++db) {
                const s16x4v va = __builtin_bit_cast(s16x4v, __builtin_amdgcn_ds_read_tr16_b64_v4i16((LAS s16x4v*)(lds + VL + k0 * 128 + ((db ^ f0) << 5) + 8 * rp)));
                const s16x4v vb = __builtin_bit_cast(s16x4v, __builtin_amdgcn_ds_read_tr16_b64_v4i16((LAS s16x4v*)(lds + VL + k1 * 128 + ((db ^ f1) << 5) + 8 * rp)));
                const bf16x8v vf = __builtin_shufflevector(va, vb, 0, 1, 2, 3, 4, 5, 6, 7);
                o[db] = __builtin_amdgcn_mfma_f32_16x16x32_bf16(vf, pf, o[db], 0, 0, 0); } } }
    const float il = 1.0f / lsum; bf16* op = OB + ((size_t)u.br * NTOK + qtok) * 1024 + u.h * 64 + 4 * g;
#pragma unroll
    for (int db = 0; db < 4; ++db) { v2u wv; wv.x = pk2(o[db][0] * il, o[db][1] * il); wv.y = pk2(o[db][2] * il, o[db][3] * il); *(GAS v2u*)(op + 16 * db) = wv; }
    if (g == 0) LSE[((size_t)u.br * NTOK + qtok) * 16 + u.h] = (mx + __builtin_amdgcn_logf(lsum)) * 0.6931471805599453f;
}
__device__ __forceinline__ void attn_phase(const Args& a, LAS unsigned char* lds, int unit0, int stride, int uend, int wave) {
    const bf16* PROJ = (const bf16*)(a.ws + WS_PROJ);
    const int lane = fresh_lane(), ql = lane & 15, g = lane >> 4; const unsigned lds0 = (unsigned)(uintptr_t)lds;
    if (unit0 >= uend) return;
    asm volatile("s_waitcnt vmcnt(0) lgkmcnt(0)" ::: "memory"); __builtin_amdgcn_s_barrier(); asm volatile("" ::: "memory");
    AttnU u = attn_decode(unit0); attn_issue(a, lds0, 0, u, wave, lane);
    bf16x8v bq0, bq1;
    { const size_t qtok = (size_t)u.b * SEQ + (u.n * 128 + 16 * wave + ql) * u.d + u.r; const bf16* qp = PROJ + qtok * NIN + u.h * 64;
      bq0 = *(const GAS bf16x8v*)(qp + 8 * g); bq1 = *(const GAS bf16x8v*)(qp + 32 + 8 * g); }
    int cur = 0;
    for (int un = unit0; un < uend; un += stride) {
        asm volatile("s_waitcnt vmcnt(0)" ::: "memory"); __builtin_amdgcn_s_barrier(); asm volatile("" ::: "memory");
        const bool more = un + stride < uend; AttnU v = u; bf16x8v nq0 = bq0, nq1 = bq1;
        if (more) { v = attn_decode(un + stride); attn_issue(a, lds0, (cur ^ 1) * 65536, v, wave, lane);
            const size_t qtok = (size_t)v.b * SEQ + (v.n * 128 + 16 * wave + ql) * v.d + v.r; const bf16* qp = PROJ + qtok * NIN + v.h * 64;
            nq0 = *(const GAS bf16x8v*)(qp + 8 * g); nq1 = *(const GAS bf16x8v*)(qp + 32 + 8 * g); }
        attn_compute(a, lds, cur * 65536, u, wave, lane, bq0, bq1);
        u = v; bq0 = nq0; bq1 = nq1; cur ^= 1; }
    asm volatile("s_waitcnt vmcnt(0) lgkmcnt(0)" ::: "memory"); __builtin_amdgcn_s_barrier(); asm volatile("" ::: "memory");
}
__device__ __forceinline__ s16x4v trrd(const LAS unsigned char* p) { return __builtin_bit_cast(s16x4v, __builtin_amdgcn_ds_read_tr16_b64_v4i16((LAS s16x4v*)p)); }
__device__ __forceinline__ bf16x8v cat8(s16x4v a, s16x4v b) { return __builtin_shufflevector(a, b, 0, 1, 2, 3, 4, 5, 6, 7); }
__device__ __forceinline__ int hg_fsw(int k) { return ((k >> 1) & 1) | (((k >> 3) & 1) << 1); }
__device__ __forceinline__ int hg_row32(int r) { return (r * 32) ^ (((r >> 3) & 1) << 7); }
__device__ __forceinline__ void hgrn_prep(const Args& a, LAS unsigned char* lds, int unit, int wave) {
    const bf16* PROJ = (const bf16*)(a.ws + WS_PROJ); unsigned char* IMG = a.ws + WS_HIMG + (size_t)unit * 32768; float* SCAL = (float*)(a.ws + WS_HSC) + (size_t)unit * 256;
    const int lane = fresh_lane(), tid = wave * 64 + lane, pk = tid & 127, tg = tid >> 7;
    const int b = unit >> 8, h = (unit >> 5) & 7, ch = unit & 31;
    const float lbk = 1.0f / (1.0f + __expf(a.hgrn_lb[1024 + h * 128 + pk] - a.hgrn_lb[h * 128 + pk]));
    float fq[16], fc[16], ff[16];
    const bf16* src = PROJ + ((size_t)b * SEQ + ch * 64 + 16 * tg) * NIN + h * 128 + pk;
#pragma unroll
    for (int j = 0; j < 16; ++j) { fq[j] = __builtin_bit_cast(float, (unsigned)src[(size_t)j * NIN + 3072] << 16); ff[j] = __builtin_bit_cast(float, (unsigned)src[(size_t)j * NIN + 4096] << 16); }
#pragma unroll
    for (int j = 0; j < 16; ++j) { ff[j] = lbk + (1.0f - lbk) / (1.0f + __expf(-ff[j])); fc[j] = (j == 0) ? ff[0] : fc[j - 1] * ff[j]; }
    LAS float* TOT = (LAS float*)lds;
    __syncthreads();
    TOT[tg * 128 + pk] = fc[15];
    __syncthreads();
    const float t0 = TOT[pk], t1 = TOT[128 + pk], t2 = TOT[256 + pk], t3 = TOT[384 + pk];
    const float pref = t0 * t1, pall = pref * t2 * t3, pre = (tg == 0) ? 1.0f : (tg == 1) ? t0 : (tg == 2) ? pref : pref * t2, rpref = 1.0f / pref;
    float oq[16], ok[16];
#pragma unroll
    for (int j = 0; j < 16; ++j) { const float P = pre * fc[j]; oq[j] = fq[j] * P * rpref; ok[j] = (1.0f - ff[j]) * pref / P; }
    const int wo = pk * 128 + ((tg ^ hg_fsw(pk)) << 5);
    v4u w0, w1;
    w0.x = pg8::cvt_pk_bf16(oq[0], oq[1]); w0.y = pg8::cvt_pk_bf16(oq[2], oq[3]); w0.z = pg8::cvt_pk_bf16(oq[4], oq[5]); w0.w = pg8::cvt_pk_bf16(oq[6], oq[7]);
    w1.x = pg8::cvt_pk_bf16(oq[8], oq[9]); w1.y = pg8::cvt_pk_bf16(oq[10], oq[11]); w1.z = pg8::cvt_pk_bf16(oq[12], oq[13]); w1.w = pg8::cvt_pk_bf16(oq[14], oq[15]);
    *(GAS v4u*)(IMG + wo) = w0; *(GAS v4u*)(IMG + wo + 16) = w1;
    w0.x = pg8::cvt_pk_bf16(ok[0], ok[1]); w0.y = pg8::cvt_pk_bf16(ok[2], ok[3]); w0.z = pg8::cvt_pk_bf16(ok[4], ok[5]); w0.w = pg8::cvt_pk_bf16(ok[6], ok[7]);
    w1.x = pg8::cvt_pk_bf16(ok[8], ok[9]); w1.y = pg8::cvt_pk_bf16(ok[10], ok[11]); w1.z = pg8::cvt_pk_bf16(ok[12], ok[13]); w1.w = pg8::cvt_pk_bf16(ok[14], ok[15]);
    *(GAS v4u*)(IMG + 16384 + wo) = w0; *(GAS v4u*)(IMG + 16384 + wo + 16) = w1;
    if (tg == 0) { SCAL[pk] = pref; SCAL[128 + pk] = pall; }
}
__device__ __forceinline__ void hgrn_unit(const Args& a, LAS unsigned char* lds, int unit, int wave) {
    const bf16* PROJ = (const bf16*)(a.ws + WS_PROJ); float* ORAW = (float*)(a.ws + WS_ORAW);
    const int lane = fresh_lane(), tid = wave * 64 + lane;
    const int vs = unit & 7, h = (unit >> 3) & 7, b = unit >> 6;
    const unsigned char* IMG = a.ws + WS_HIMG + (size_t)((b * 8 + h) * 32) * 32768; const float* SCAL = (const float*)(a.ws + WS_HSC) + (size_t)((b * 8 + h) * 32) * 256;
    constexpr int BUF = 36864, OQT = 0, OKT = 16384, OV = 32768, OSC = 34816, ST = 73728;
    const int i16 = lane & 15, g = lane >> 4, rq = i16 >> 2, rp = i16 & 3; const unsigned lds0 = (unsigned)(uintptr_t)lds;
#define HG_BAR() do { asm volatile("" ::: "memory"); __builtin_amdgcn_s_barrier(); asm volatile("" ::: "memory"); } while (0)
#define HG_ISSUE(ch, bo) do { const unsigned char* gsrc = IMG + (size_t)(ch) * 32768 + tid * 16; \
        _Pragma("unroll") for (int r = 0; r < 4; ++r) glds16(gsrc + r * 8192, (unsigned)__builtin_amdgcn_readfirstlane((int)(lds0 + (bo) + wave * 1024 + r * 8192))); \
        { const int idx = tid * 2, t = idx >> 4, v = idx & 15; pi = *(const GAS unsigned*)(PROJ + ((size_t)b * SEQ + (ch) * 64 + t) * NIN + 5120 + h * 128 + vs * 16 + v); } \
        psc = (tid < 256) ? SCAL[(size_t)(ch) * 256 + tid] : 0.f; } while (0)
#define HG_LAND(bo) do { { const int idx = tid * 2, t = idx >> 4, v = idx & 15; *(LAS unsigned*)(lds + (bo) + OV + hg_row32(t) + v * 2) = pi; } \
        if (tid < 256) ((LAS float*)(lds + (bo) + OSC))[tid] = psc; asm volatile("s_waitcnt vmcnt(0) lgkmcnt(0)" ::: "memory"); } while (0)
    unsigned pi; float psc;
    asm volatile("s_waitcnt vmcnt(0) lgkmcnt(0)" ::: "memory"); HG_BAR();
    HG_ISSUE(0, 0); HG_LAND(0);
    f32x4 S[2]; S[0] = (f32x4){0.f, 0.f, 0.f, 0.f}; S[1] = S[0];
    for (int ch = 0; ch < 32; ++ch) {
        const int bc = (ch & 1) * BUF, bn = BUF - bc;
        HG_BAR();
        if (wave >= 4) {
#pragma unroll
            for (int q2 = 0; q2 < 2; ++q2) { const int k = 16 * (2 * (wave - 4) + q2) + i16; const float pr = ((const LAS float*)(lds + bc + OSC))[k];
                v2u w; w.x = pg8::cvt_pk_bf16(S[q2][0] * pr, S[q2][1] * pr); w.y = pg8::cvt_pk_bf16(S[q2][2] * pr, S[q2][3] * pr); *(LAS v2u*)(lds + ST + hg_row32(k) + 8 * g) = w; } }
        if (ch + 1 < 32) HG_ISSUE(ch + 1, bn);
        asm volatile("s_waitcnt lgkmcnt(0)" ::: "memory"); HG_BAR();
        if (wave < 4) {
            const int w = wave; f32x4 acc = (f32x4){0.f, 0.f, 0.f, 0.f}; bf16x8v Bq[4];
#pragma unroll
            for (int ks = 0; ks < 4; ++ks) { const int k0 = 32 * ks + 8 * g + rq, k1 = k0 + 4;
                Bq[ks] = cat8(trrd(lds + bc + OQT + k0 * 128 + ((w ^ hg_fsw(k0)) << 5) + 8 * rp), trrd(lds + bc + OQT + k1 * 128 + ((w ^ hg_fsw(k1)) << 5) + 8 * rp));
                const bf16x8v A = cat8(trrd(lds + ST + hg_row32(k0) + 8 * rp), trrd(lds + ST + hg_row32(k1) + 8 * rp));
                acc = __builtin_amdgcn_mfma_f32_16x16x32_bf16(A, Bq[ks], acc, 0, 0, 0); }
            f32x4 p[4];
#pragma unroll
            for (int st = 0; st < 4; ++st) { p[st] = (f32x4){0.f, 0.f, 0.f, 0.f};
                if (st <= w) { f32x4 d = (f32x4){0.f, 0.f, 0.f, 0.f};
#pragma unroll
                    for (int ks = 0; ks < 4; ++ks) { const int k0 = 32 * ks + 8 * g + rq, k1 = k0 + 4;
                        const bf16x8v A = cat8(trrd(lds + bc + OKT + k0 * 128 + ((st ^ hg_fsw(k0)) << 5) + 8 * rp), trrd(lds + bc + OKT + k1 * 128 + ((st ^ hg_fsw(k1)) << 5) + 8 * rp));
                        d = __builtin_amdgcn_mfma_f32_16x16x32_bf16(A, Bq[ks], d, 0, 0, 0); }
                    if (st == w) {
#pragma unroll
                        for (int e = 0; e < 4; ++e) if (4 * g + e > i16) d[e] = 0.f; }
                    p[st] = d; } }
#pragma unroll
            for (int pr = 0; pr < 2; ++pr) { const int s0 = 2 * pr, s1 = 2 * pr + 1;
                if (s0 <= w) { const int s1a = (s1 <= w) ? s1 : s0;
                    v4u pw; pw.x = pg8::cvt_pk_bf16(p[s0][0], p[s0][1]); pw.y = pg8::cvt_pk_bf16(p[s0][2], p[s0][3]); pw.z = (s1 <= w) ? pg8::cvt_pk_bf16(p[s1][0], p[s1][1]) : 0u; pw.w = (s1 <= w) ? pg8::cvt_pk_bf16(p[s1][2], p[s1][3]) : 0u;
                    const bf16x8v V = cat8(trrd(lds + bc + OV + hg_row32(16 * s0 + 4 * g + rq) + 8 * rp), trrd(lds + bc + OV + hg_row32(16 * s1a + 4 * g + rq) + 8 * rp));
                    acc = __builtin_amdgcn_mfma_f32_16x16x32_bf16(V, __builtin_bit_cast(bf16x8v, pw), acc, 0, 0, 0); } }
            *(GAS f32x4*)(ORAW + ((size_t)b * SEQ + ch * 64 + 16 * w + i16) * 1024 + h * 128 + vs * 16 + 4 * g) = acc;
        } else {
#pragma unroll
            for (int q2 = 0; q2 < 2; ++q2) { const int k = 16 * (2 * (wave - 4) + q2) + i16;
                const float pr = ((const LAS float*)(lds + bc + OSC))[k], pa = ((const LAS float*)(lds + bc + OSC))[128 + k];
                f32x4 d = (f32x4){0.f, 0.f, 0.f, 0.f};
#pragma unroll
                for (int ss = 0; ss < 2; ++ss) { const int s0 = 32 * ss + 8 * g + rq;
                    const bf16x8v A = cat8(trrd(lds + bc + OV + hg_row32(s0) + 8 * rp), trrd(lds + bc + OV + hg_row32(s0 + 4) + 8 * rp));
                    const bf16x8v B = *(const LAS bf16x8v*)(lds + bc + OKT + k * 128 + (((2 * ss + (g >> 1)) ^ hg_fsw(k)) << 5) + (g & 1) * 16);
                    d = __builtin_amdgcn_mfma_f32_16x16x32_bf16(A, B, d, 0, 0, 0); }
                S[q2] = S[q2] * pa + d * (pa * __builtin_amdgcn_rcpf(pr)); }
        }
        if (ch + 1 < 32) HG_LAND(bn); else asm volatile("s_waitcnt vmcnt(0) lgkmcnt(0)" ::: "memory");
    }
#undef HG_ISSUE
#undef HG_LAND
    HG_BAR();
#undef HG_BAR
}
__device__ __forceinline__ void p3b_rec(const Args& a, int gw, int NGW, int lane) {
    const bf16* PROJ = (const bf16*)(a.ws + WS_PROJ); const float* ORAW = (const float*)(a.ws + WS_ORAW); bf16* MIXED = (bf16*)(a.ws + WS_MIXED);
    for (int tok = gw; tok < NTOK; tok += NGW) {
        const float* op = ORAW + (size_t)tok * 1024 + 16 * lane; float o[16]; float ss = 0.f;
#pragma unroll
        for (int j = 0; j < 4; ++j) { const f32x4 v = *(const GAS f32x4*)(op + 4 * j); o[4 * j] = v[0]; o[4 * j + 1] = v[1]; o[4 * j + 2] = v[2]; o[4 * j + 3] = v[3]; ss += (v[0] * v[0] + v[1] * v[1]) + (v[2] * v[2] + v[3] * v[3]); }
        ss += __shfl_xor(ss, 1); ss += __shfl_xor(ss, 2); ss += __shfl_xor(ss, 4);
        const float r = 1.0f / sqrtf(ss * (1.0f / 128.0f) + 1e-6f);
        const bf16* gp = PROJ + (size_t)tok * NIN + 6144 + 16 * lane; const float* gn = a.gnorm_w + 16 * lane; float g[16];
        { const v4u w0 = *(const GAS v4u*)gp, w1 = *(const GAS v4u*)(gp + 8); const unsigned ww[8] = {w0.x, w0.y, w0.z, w0.w, w1.x, w1.y, w1.z, w1.w};
#pragma unroll
            for (int e = 0; e < 8; ++e) { g[2 * e] = bflo(ww[e]); g[2 * e + 1] = bfhi(ww[e]); } }
        float y[16];
#pragma unroll
        for (int e = 0; e < 16; ++e) y[e] = o[e] * r * gn[e] * (g[e] / (1.0f + __expf(-g[e])));
        bf16* mp = MIXED + (size_t)tok * DM + 1024 + 16 * lane;
        v4u w; w.x = pk2(y[0], y[1]); w.y = pk2(y[2], y[3]); w.z = pk2(y[4], y[5]); w.w = pk2(y[6], y[7]); *(GAS v4u*)mp = w;
        w.x = pk2(y[8], y[9]); w.y = pk2(y[10], y[11]); w.z = pk2(y[12], y[13]); w.w = pk2(y[14], y[15]); *(GAS v4u*)(mp + 8) = w;
        { const bf16* OB = (const bf16*)(a.ws + WS_OB); const float* LSE = (const float*)(a.ws + WS_LSE); const int hd = lane >> 2;
            const float l0 = LSE[((size_t)0 * NTOK + tok) * 16 + hd], l1 = LSE[((size_t)1 * NTOK + tok) * 16 + hd], l2 = LSE[((size_t)2 * NTOK + tok) * 16 + hd];
            const float lm = fmaxf(l0, fmaxf(l1, l2)); float wt[3] = {__expf(l0 - lm), __expf(l1 - lm), __expf(l2 - lm)}; const float inv = 1.0f / (wt[0] + wt[1] + wt[2]);
            float acc[16];
#pragma unroll
            for (int e = 0; e < 16; ++e) acc[e] = 0.f;
#pragma unroll
            for (int i = 0; i < 3; ++i) { const bf16* p = OB + ((size_t)i * NTOK + tok) * 1024 + 16 * lane; const v4u w0 = *(const GAS v4u*)p, w1 = *(const GAS v4u*)(p + 8); float t0[8], t1[8]; unpack8(w0, t0); unpack8(w1, t1); const float ww = wt[i] * inv;
#pragma unroll
                for (int e = 0; e < 8; ++e) { acc[e] += ww * t0[e]; acc[8 + e] += ww * t1[e]; } }
            bf16* ap = MIXED + (size_t)tok * DM + 16 * lane; float lo[8], hi[8];
#pragma unroll
            for (int e = 0; e < 8; ++e) { lo[e] = acc[e]; hi[e] = acc[8 + e]; }
            *(GAS v4u*)ap = pack8(lo); *(GAS v4u*)(ap + 8) = pack8(hi); }
    }
}
__device__ __forceinline__ void p5a_row2(const Args& a, const int row0, int lane) {
    const float* MOD = (const float*)(a.ws + WS_MOD); const bf16* MIXB = (const bf16*)(a.ws + WS_MIXF); bf16* X1 = (bf16*)(a.ws + WS_X1); unsigned char* H2 = a.ws + WS_H;
    const unsigned vo = (unsigned)lane * 16u;
    const int b = row0 >> 11; const float* mb = MOD + b * 12288; const float* xr = a.x + (size_t)row0 * DM; const bf16* mr = MIXB + (size_t)row0 * DM;
    bf16* x1r = X1 + (size_t)row0 * DM; unsigned char* h2r = H2 + (size_t)row0 * DM;
    f32x4 v0[8], v1[8]; float s0 = 0.f, s1 = 0.f;
#pragma unroll
    for (int j = 0; j < 8; ++j) { const f32x4 gt = ldg4(mb + 4096 + 256 * j, vo) + 1.0f, xa = ldg4(xr + 256 * j, vo), xb = ldg4(xr + DM + 256 * j, vo); const v2u ma = ldg2(mr + 256 * j, vo >> 1), mc = ldg2(mr + DM + 256 * j, vo >> 1);
        v0[j] = xa * ALPHA_DN + gt * (f32x4){bflo(ma.x), bfhi(ma.x), bflo(ma.y), bfhi(ma.y)}; v1[j] = xb * ALPHA_DN + gt * (f32x4){bflo(mc.x), bfhi(mc.x), bflo(mc.y), bfhi(mc.y)};
        s0 += (v0[j][0] + v0[j][1]) + (v0[j][2] + v0[j][3]); s1 += (v1[j][0] + v1[j][1]) + (v1[j][2] + v1[j][3]); }
    const float mean0 = wave_sum(s0) * (1.0f / DM), mean1 = wave_sum(s1) * (1.0f / DM); float q0 = 0.f, q1 = 0.f;
#pragma unroll
    for (int j = 0; j < 8; ++j) { v0[j] = v0[j] - mean0; v1[j] = v1[j] - mean1; q0 += (v0[j][0] * v0[j][0] + v0[j][1] * v0[j][1]) + (v0[j][2] * v0[j][2] + v0[j][3] * v0[j][3]);
        q1 += (v1[j][0] * v1[j][0] + v1[j][1] * v1[j][1]) + (v1[j][2] * v1[j][2] + v1[j][3] * v1[j][3]); }
    const float rstd0 = 1.0f / sqrtf(wave_sum(q0) * (1.0f / DM) + 1e-5f), rstd1 = 1.0f / sqrtf(wave_sum(q1) * (1.0f / DM) + 1e-5f);
#pragma unroll
    for (int j = 0; j < 8; ++j) { const f32x4 g = ldg4(a.ln1_g + 256 * j, vo), bb = ldg4(a.ln1_b + 256 * j, vo), sh = ldg4(mb + 3 * 2048 + 256 * j, vo), sc = ldg4(mb + 4 * 2048 + 256 * j, vo) + 1.0f;
        const f32x4 xa = v0[j] * rstd0 * g + bb, xb = v1[j] * rstd1 * g + bb;
        { v2u wa, wb; wa.x = pk2(xa[0], xa[1]); wa.y = pk2(xa[2], xa[3]); wb.x = pk2(xb[0], xb[1]); wb.y = pk2(xb[2], xb[3]); *(GAS v2u*)((GAS unsigned char*)(x1r + 256 * j) + (vo >> 1)) = wa; *(GAS v2u*)((GAS unsigned char*)(x1r + DM + 256 * j) + (vo >> 1)) = wb; }
        const f32x4 ha = xa * sc + sh, hb = xb * sc + sh; unsigned w = 0u, w2 = 0u;
        w = __builtin_amdgcn_cvt_pk_fp8_f32(ha[0], ha[1], w, false); w = __builtin_amdgcn_cvt_pk_fp8_f32(ha[2], ha[3], w, true); *(GAS unsigned*)((GAS unsigned char*)(h2r + 256 * j) + (vo >> 2)) = w;
        w2 = __builtin_amdgcn_cvt_pk_fp8_f32(hb[0], hb[1], w2, false); w2 = __builtin_amdgcn_cvt_pk_fp8_f32(hb[2], hb[3], w2, true); *(GAS unsigned*)((GAS unsigned char*)(h2r + DM + 256 * j) + (vo >> 2)) = w2; }
}
__device__ __forceinline__ void p5_ln_router(const Args& a, LAS unsigned char* lds, int blk, int nblk, int wave) {
    const bf16* X1 = (const bf16*)(a.ws + WS_X1); const float* MOD = (const float*)(a.ws + WS_MOD); const bf16* RH = (const bf16*)(a.ws + WS_RWT); const bf16* RL = RH + NEXP * DM;
    gu32* cnt = (gu32*)(a.ws + WS_CTL) + CW_CNT; int* AR = (int*)(a.ws + WS_ASG); float* RG = (float*)(a.ws + WS_RGATE); int* RT = (int*)(a.ws + WS_ROWTOK);
    const int lane = fresh_lane(), i16 = lane & 15, g = lane >> 4;
    LAS float* part = (LAS float*)lds;
    for (int t0 = blk; t0 < NTOK / 16; t0 += 3 * nblk) {
        const int nt = (t0 + 2 * nblk < NTOK / 16) ? 3 : (t0 + nblk < NTOK / 16) ? 2 : 1;
#pragma unroll 1
        for (int t = 0; t < nt; ++t) p5a_row2(a, (t0 + t * nblk) * 16 + 2 * wave, lane);
        asm volatile("s_waitcnt vmcnt(0)" ::: "memory"); __syncthreads();
        f32x4 acc[3][2];
#pragma unroll
        for (int t = 0; t < 3; ++t) { acc[t][0] = (f32x4){0.f, 0.f, 0.f, 0.f}; acc[t][1] = acc[t][0]; }
        const unsigned lx = (unsigned)(i16 * DM + 8 * g) * 2u, lm = (unsigned)(8 * g) * 4u, lr = (unsigned)(i16 * DM + 8 * g) * 2u;
#pragma unroll 2
        for (int ks = 0; ks < 8; ++ks) { const int kw = wave * 256 + ks * 32;
            const bf16x8v b0h = __builtin_bit_cast(bf16x8v, ldg4(RH + kw, lr)), b0l = __builtin_bit_cast(bf16x8v, ldg4(RL + kw, lr));
            const bf16x8v b1h = __builtin_bit_cast(bf16x8v, ldg4(RH + 16 * DM + kw, lr)), b1l = __builtin_bit_cast(bf16x8v, ldg4(RL + 16 * DM + kw, lr));
#pragma unroll
            for (int t = 0; t < 3; ++t) if (t < nt) { const int tile = t0 + t * nblk;
                const bf16* xp = X1 + (size_t)(tile * 16) * DM + kw; const float* mb = MOD + ((tile * 16) >> 11) * 12288 + kw;
                bf16x8v fah, fal;
                { float xt[8]; unpack8(__builtin_bit_cast(v4u, ldg4(xp, lx)), xt); const f32x4 xa = (f32x4){xt[0], xt[1], xt[2], xt[3]}, xb = (f32x4){xt[4], xt[5], xt[6], xt[7]}, sa = ldg4(mb + 4 * 2048, lm), sb = ldg4(mb + 4 * 2048 + 4, lm), ha = ldg4(mb + 3 * 2048, lm), hb = ldg4(mb + 3 * 2048 + 4, lm);
                  const f32x4 h0 = xa * (sa + 1.0f) + ha, h1 = xb * (sb + 1.0f) + hb; unsigned hi[4], lo[4];
#pragma unroll
                  for (int q = 0; q < 2; ++q) { const unsigned a0 = f2bf(h0[2 * q]), a1 = f2bf(h0[2 * q + 1]), c0 = f2bf(h1[2 * q]), c1 = f2bf(h1[2 * q + 1]);
                      hi[q] = a0 | (a1 << 16); hi[2 + q] = c0 | (c1 << 16);
                      lo[q] = pk2(h0[2 * q] - __builtin_bit_cast(float, a0 << 16), h0[2 * q + 1] - __builtin_bit_cast(float, a1 << 16)); lo[2 + q] = pk2(h1[2 * q] - __builtin_bit_cast(float, c0 << 16), h1[2 * q + 1] - __builtin_bit_cast(float, c1 << 16)); }
                  v4u vh, vl; vh.x = hi[0]; vh.y = hi[1]; vh.z = hi[2]; vh.w = hi[3]; vl.x = lo[0]; vl.y = lo[1]; vl.z = lo[2]; vl.w = lo[3];
                  fah = __builtin_bit_cast(bf16x8v, vh); fal = __builtin_bit_cast(bf16x8v, vl); }
                acc[t][0] = __builtin_amdgcn_mfma_f32_16x16x32_bf16(fah, b0h, acc[t][0], 0, 0, 0); acc[t][0] = __builtin_amdgcn_mfma_f32_16x16x32_bf16(fah, b0l, acc[t][0], 0, 0, 0); acc[t][0] = __builtin_amdgcn_mfma_f32_16x16x32_bf16(fal, b0h, acc[t][0], 0, 0, 0);
                acc[t][1] = __builtin_amdgcn_mfma_f32_16x16x32_bf16(fah, b1h, acc[t][1], 0, 0, 0); acc[t][1] = __builtin_amdgcn_mfma_f32_16x16x32_bf16(fah, b1l, acc[t][1], 0, 0, 0); acc[t][1] = __builtin_amdgcn_mfma_f32_16x16x32_bf16(fal, b1h, acc[t][1], 0, 0, 0); } }
        __syncthreads();
#pragma unroll
        for (int t = 0; t < 3; ++t) if (t < nt) {
#pragma unroll
            for (int e = 0; e < 4; ++e) { part[((t * 8 + wave) * 16 + 4 * g + e) * 33 + i16] = acc[t][0][e]; part[((t * 8 + wave) * 16 + 4 * g + e) * 33 + 16 + i16] = acc[t][1][e]; } }
        __syncthreads();
        if (wave < nt && lane < 16) { const int row = (t0 + wave * nblk) * 16 + lane; float lg[32];
#pragma unroll
            for (int e = 0; e < 32; ++e) { float sacc = a.router_b[e];
#pragma unroll
                for (int w = 0; w < 8; ++w) sacc += part[((wave * 8 + w) * 16 + lane) * 33 + e];
                lg[e] = sacc; }
            float bv[4]; int bi[4];
#pragma unroll
            for (int q = 0; q < 4; ++q) { float best = -3.0e38f; int idx = 0;
#pragma unroll
                for (int e = 0; e < 32; ++e) { const bool taken = (q > 0 && e == bi[0]) || (q > 1 && e == bi[1]) || (q > 2 && e == bi[2]); if (!taken && lg[e] > best) { best = lg[e]; idx = e; } }
                bv[q] = best; bi[q] = idx; }
            const float e1 = __expf(bv[1] - bv[0]), e2 = __expf(bv[2] - bv[0]), e3 = __expf(bv[3] - bv[0]), inv = 1.0f / (1.0f + e1 + e2 + e3);
            const float gts[4] = {inv, e1 * inv, e2 * inv, e3 * inv};
#pragma unroll
            for (int q = 0; q < 4; ++q) { const unsigned p = __hip_atomic_fetch_add(cnt + 16 * bi[q], 1u, RLX_AGENT); const int er = bi[q] * ECAP + (int)p; AR[row * 4 + q] = er; RG[er] = gts[q]; RT[er] = row; } }
    }
    __syncthreads();
}
__device__ __forceinline__ void moe_tables(const Args& a, LAS unsigned char* lds, int tid) {
    LAS int* tb = (LAS int*)(lds + TAB_OFF);
    if (tid < 64) {
        const gu32* cnt = (const gu32*)(a.ws + WS_CTL) + CW_CNT; const int e = tid & 31;
        const int n = (tid < 32) ? (int)__hip_atomic_load(cnt + 16 * e, RLX_AGENT) : 0; const int nt = (n + 255) >> 8;
        int incl = nt;
#pragma unroll
        for (int d = 1; d < 32; d <<= 1) { const int o = __shfl_up(incl, d); if (tid >= d) incl += o; }
        const int t0 = incl - nt;
        if (tid < 32) { tb[e] = t0 < 160 ? t0 : 160; for (int i = 0; i < nt && t0 + i < 160; ++i) tb[64 + t0 + i] = e * ETILES + i; }
        if (tid == 31) tb[32] = incl < 160 ? incl : 160;
    }
    __syncthreads();
}
__device__ __forceinline__ void p9_final(const Args& a, int gw, int NGW, int lane) {
    const float* MOD = (const float*)(a.ws + WS_MOD); const bf16* X1 = (const bf16*)(a.ws + WS_X1); const unsigned char* Y = a.ws + WS_Y;
    const int* AR = (const int*)(a.ws + WS_ASG); const unsigned vo = (unsigned)lane * 16u, vq = (unsigned)lane * 4u;
    for (int row = gw; row < NTOK; row += NGW) { const int b = row >> 11; const float* mb = MOD + b * 12288 + 5 * 2048; const bf16* xr = X1 + (size_t)row * DM; float* orow = a.out + (size_t)row * DM;
        const unsigned char* y0 = Y + (size_t)__builtin_amdgcn_readfirstlane(AR[row * 4]) * DM; const unsigned char* y1 = Y + (size_t)__builtin_amdgcn_readfirstlane(AR[row * 4 + 1]) * DM;
        const unsigned char* y2 = Y + (size_t)__builtin_amdgcn_readfirstlane(AR[row * 4 + 2]) * DM; const unsigned char* y3 = Y + (size_t)__builtin_amdgcn_readfirstlane(AR[row * 4 + 3]) * DM;
        f32x4 v[8]; float s = 0.f;
#pragma unroll
        for (int j = 0; j < 8; ++j) { const v2u xw = ldg2(xr + 256 * j, vo >> 1); const f32x4 xv = (f32x4){bflo(xw.x), bfhi(xw.x), bflo(xw.y), bfhi(xw.y)}, gt = ldg4(mb + 256 * j, vo);
            const unsigned w0 = *(const GAS unsigned*)((const GAS unsigned char*)(y0 + 256 * j) + vq), w1 = *(const GAS unsigned*)((const GAS unsigned char*)(y1 + 256 * j) + vq), w2 = *(const GAS unsigned*)((const GAS unsigned char*)(y2 + 256 * j) + vq), w3 = *(const GAS unsigned*)((const GAS unsigned char*)(y3 + 256 * j) + vq);
            f32x4 ff;
            ff[0] = ((__builtin_amdgcn_cvt_f32_fp8(w0, 0) + __builtin_amdgcn_cvt_f32_fp8(w1, 0)) + __builtin_amdgcn_cvt_f32_fp8(w2, 0)) + __builtin_amdgcn_cvt_f32_fp8(w3, 0);
            ff[1] = ((__builtin_amdgcn_cvt_f32_fp8(w0, 1) + __builtin_amdgcn_cvt_f32_fp8(w1, 1)) + __builtin_amdgcn_cvt_f32_fp8(w2, 1)) + __builtin_amdgcn_cvt_f32_fp8(w3, 1);
            ff[2] = ((__builtin_amdgcn_cvt_f32_fp8(w0, 2) + __builtin_amdgcn_cvt_f32_fp8(w1, 2)) + __builtin_amdgcn_cvt_f32_fp8(w2, 2)) + __builtin_amdgcn_cvt_f32_fp8(w3, 2);
            ff[3] = ((__builtin_amdgcn_cvt_f32_fp8(w0, 3) + __builtin_amdgcn_cvt_f32_fp8(w1, 3)) + __builtin_amdgcn_cvt_f32_fp8(w2, 3)) + __builtin_amdgcn_cvt_f32_fp8(w3, 3);
            v[j] = xv * ALPHA_DN + (gt + 1.0f) * ff; s += (v[j][0] + v[j][1]) + (v[j][2] + v[j][3]); }
        const float mean = wave_sum(s) * (1.0f / DM); float s2 = 0.f;
#pragma unroll
        for (int j = 0; j < 8; ++j) { v[j] = v[j] - mean; s2 += (v[j][0] * v[j][0] + v[j][1] * v[j][1]) + (v[j][2] * v[j][2] + v[j][3] * v[j][3]); }
        const float rstd = 1.0f / sqrtf(wave_sum(s2) * (1.0f / DM) + 1e-5f);
#pragma unroll
        for (int j = 0; j < 8; ++j) { const f32x4 g = ldg4(a.ln2_g + 256 * j, vo), bb = ldg4(a.ln2_b + 256 * j, vo); stg4(orow + 256 * j, vo, v[j] * rstd * g + bb); } }
}

__global__ void __launch_bounds__(NWAVES * 64, 2) fwd(Args a) {
    extern __shared__ __attribute__((aligned(16))) unsigned char lds_raw[];
    LAS unsigned char* lds = (LAS unsigned char*)lds_raw;
    const int wave = wave_id();
#define TID (wave * 64 + fresh_lane())
#define LANE fresh_lane()
    const int G = gridDim.x, gw = blockIdx.x * NWAVES + wave, NGW = G * NWAVES;
    for (int u = TID; u < (LDS_BYTES - LDSCTL_OFF) / 4; u += NWAVES * 64) ((LAS unsigned*)(lds + LDSCTL_OFF))[u] = 0u;
    __syncthreads();
    constexpr int CK = 2;
    const int bx = blockIdx.x; const bool split = (G == 256); const int oct = (bx >> 3) & 7; const bool conv = split && (oct >= 8 - CK);
    const int Gc = split ? (256 - 32 * CK) : G, Gv = 32 * CK;
    const int cidx = !split ? bx : conv ? ((bx >> 6) * (CK * 8) + (oct - (8 - CK)) * 8 + (bx & 7)) : ((bx >> 6) * ((8 - CK) * 8) + oct * 8 + (bx & 7));
    const int gwc = cidx * NWAVES + wave, NGWc = Gc * NWAVES;
    XcdBarrier bar = xcd_barrier_post((unsigned*)(a.ws + WS_CTL) + CW_BAR, (volatile LAS unsigned*)(lds + MISC_OFF) + 8, wave, (unsigned)G);
    XcdBarrier bsub = bar;
    if (split && !conv) bsub = xcd_barrier_post((unsigned*)(a.ws + WS_CTL) + CW_BAR2, (volatile LAS unsigned*)(lds + MISC_OFF) + 12, wave, (unsigned)Gc);

    if (conv) {
        conv8_weights_dyn(a, LANE, TR8_ITEMS);
    } else {
    p0_mod(a, lds, TID, cidx, Gc);
    p0_weights(a, gwc, NGWc, LANE, 0, TR_ITEMS_DENSE);
    if (!split) conv8_weights(a, gw, NGW, LANE, 0, TR8_ITEMS);
    p0_small(a, gwc, NGWc, LANE);
    xcd_barrier(bsub);
    p1_h(a, gwc, NGWc, LANE);
    xcd_barrier(bsub);
    { pg8::Gemm g{(const pg8::bf16_t*)(a.ws + WS_H), (const pg8::bf16_t*)(a.ws + WS_WINT), NTOK, NIN, DM, nullptr}; pg8::StaticOrder S; S.init(NTOK, NIN, Gc, cidx);
      pg8::EpiProj E{(pg8::bf16_t*)(a.ws + WS_PROJ), NIN, (const float*)(a.ws + WS_TAB)};
      pg8::gemm_phase<pg8::EpiProj, pg8::StaticOrder, true, true>(lds, g, S, E, wave); }
    xcd_barrier(bsub);
    for (int u = cidx; u < 1024; u += Gc) hgrn_prep(a, lds, u, wave);
    xcd_barrier(bsub);
    for (int u = cidx; u < 256; u += Gc) hgrn_unit(a, lds, u, wave);
    if (split && Gc == 192) { if (cidx < 64) attn_phase(a, lds, cidx, 64, 512, wave); else attn_phase(a, lds, 512 + (cidx - 64), 128, 3072, wave); }
    else attn_phase(a, lds, cidx, Gc, 3072, wave);
    xcd_barrier(bsub);
    p3b_rec(a, gwc, NGWc, LANE);
    xcd_barrier(bsub);
    { pg8::Gemm g{(const pg8::bf16_t*)(a.ws + WS_MIXED), (const pg8::bf16_t*)(a.ws + WS_WOT), NTOK, DM, DM, nullptr}; pg8::StaticOrder S; S.init(NTOK, DM, Gc, cidx);
      pg8::EpiStoreBf16 E{(pg8::bf16_t*)(a.ws + WS_MIXF), DM};
      pg8::gemm_phase<pg8::EpiStoreBf16, pg8::StaticOrder, true, true>(lds, g, S, E, wave); }
    xcd_barrier(bsub);
    p5_ln_router(a, lds, cidx, Gc, wave);
    if (split) conv8_weights_dyn(a, LANE, TR8_ITEMS);
    }
    xcd_barrier(bar);
    moe_tables(a, lds, TID);
    const int NT = __builtin_amdgcn_readfirstlane(((const LAS int*)(lds + TAB_OFF))[32]);
    { pg8::Gemm g{(const pg8::bf16_t*)(a.ws + WS_H), (const pg8::bf16_t*)(a.ws + WS_W1T), NT * 256, 4096, DM / 2, (const int*)(a.ws + WS_ROWTOK)}; pg8::MoeOrder S; S.init(NT * 256, 4096, G, (int)blockIdx.x); S.tile_e = (const LAS int*)(lds + TAB_OFF) + 64;
      pg8::EpiSwiGLU E{a.ws + WS_ACT, (const float*)(a.ws + WS_B1P), 1.0f / W8_SCALE};
      pg8::gemm_phase<pg8::EpiSwiGLU, pg8::MoeOrder, true, true, true, true>(lds, g, S, E, wave); }
    xcd_barrier(bar);
    { pg8::Gemm g{(const pg8::bf16_t*)(a.ws + WS_ACT), (const pg8::bf16_t*)(a.ws + WS_W2T), NT * 256, 2048, FFE / 2, nullptr}; pg8::MoeOrder S; S.init(NT * 256, 2048, G, (int)blockIdx.x); S.tile_e = (const LAS int*)(lds + TAB_OFF) + 64;
      pg8::EpiMoeOut E{a.ws + WS_Y, a.b2, (const float*)(a.ws + WS_RGATE), 1.0f / W8_SCALE};
      pg8::gemm_phase<pg8::EpiMoeOut, pg8::MoeOrder, true, true, true>(lds, g, S, E, wave); }
    { const int nu = NT * 8, G_ = (int)G, mine = (nu - (int)blockIdx.x + G_ - 1) / G_, most = (nu + G_ - 1) / G_;
      if (mine < most) { const int idle = G_ - (nu - (most - 1) * G_), r = (int)blockIdx.x - (nu - (most - 1) * G_);
          const unsigned char* xb = a.ws + WS_X1; const size_t total = (size_t)NTOK * DM * 2, per = (total / (size_t)idle) & ~(size_t)8191; const unsigned char* p = xb + (size_t)r * per; unsigned acc = 0u;
          for (size_t o = (size_t)(TID) * 16; o < per; o += 512 * 16) { const v4u w = *(const GAS v4u*)(p + o); acc ^= w.x ^ w.y ^ w.z ^ w.w; }
          if (acc == 0x9E3779B9u) ((unsigned*)(a.ws + WS_CTL))[60] = acc; } }
    xcd_barrier(bar);
    p9_final(a, gw, NGW, LANE);
#undef TID
#undef LANE
}

extern "C" void kernel_launch(void* const* d_in, const int* in_sizes, int n_in, void* d_out, int out_size, void* d_ws, size_t ws_size, hipStream_t stream) {
    static int grid = 0;
    if (grid == 0) {
        if (n_in != 19 || out_size != NTOK * DM || ws_size < WS_END) { fprintf(stderr, "kernel_launch: unexpected problem (n_in %d, out %d, ws %zu)\n", n_in, out_size, ws_size); grid = -1; return; }
        int dev = 0, cus = 0, per_cu = 0;
        if (hipGetDevice(&dev) != hipSuccess || hipDeviceGetAttribute(&cus, hipDeviceAttributeMultiprocessorCount, dev) != hipSuccess) { grid = -1; return; }
        if (hipFuncSetAttribute((const void*)fwd, hipFuncAttributeMaxDynamicSharedMemorySize, LDS_BYTES) != hipSuccess) { fprintf(stderr, "kernel_launch: hipFuncSetAttribute failed\n"); grid = -1; return; }
        if (hipOccupancyMaxActiveBlocksPerMultiprocessor(&per_cu, (const void*)fwd, NWAVES * 64, LDS_BYTES) != hipSuccess || per_cu < 1) fprintf(stderr, "kernel_launch: occupancy query says %d\n", per_cu);
        (void)hipGetLastError();
        grid = cus;
    }
    if (grid < 0) return;
    if (hipMemsetAsync((char*)d_ws + WS_CTL, 0, CTL_ZERO_BYTES, stream) != hipSuccess) return;
    Args a{};
    a.x = (const float*)d_in[0]; a.c = (const float*)d_in[1]; a.pos = (const int*)d_in[2]; a.w_ada = (const float*)d_in[3]; a.b_ada = (const float*)d_in[4]; a.w_in = (const float*)d_in[5];
    a.hgrn_lb = (const float*)d_in[6]; a.gnorm_w = (const float*)d_in[7]; a.w_o = (const float*)d_in[8]; a.ln1_g = (const float*)d_in[9]; a.ln1_b = (const float*)d_in[10];
    a.router_w = (const float*)d_in[11]; a.router_b = (const float*)d_in[12]; a.w1 = (const float*)d_in[13]; a.b1 = (const float*)d_in[14]; a.w2 = (const float*)d_in[15]; a.b2 = (const float*)d_in[16];
    a.ln2_g = (const float*)d_in[17]; a.ln2_b = (const float*)d_in[18]; a.out = (float*)d_out; a.ws = (unsigned char*)d_ws;
    hipLaunchKernelGGL(fwd, dim3(grid), dim3(NWAVES * 64), LDS_BYTES, stream, a);
}
```
